# Optimizing an MI355X kernel written in HIP

```python
import jax, jax.numpy as jnp
from jax import lax
import numpy as np

D_MODEL = 2048
BATCH = 8
SEQ = 2048
DEPTH = 1

CHUNK = 64
D_MIX = D_MODEL
HGRN_WIDTH = D_MIX // 2
HGRN_HEAD_DIM = 128
HGRN_HEADS = HGRN_WIDTH // HGRN_HEAD_DIM
CONV_CH = D_MIX - HGRN_WIDTH
CONV_K = 3
D_FF = 5632
FFN_RESIDUAL_SCALE = 0.5
RMS_EPS = 1e-6
IN_COLS = 4 * HGRN_WIDTH + 3 * CONV_CH

kernel_name = "hgrn2_shortconv_macaron_hybrid"


def rmsnorm(x, w):
    xf = x.astype(jnp.float32)
    y = xf * lax.rsqrt(jnp.mean(xf * xf, axis=-1, keepdims=True) + RMS_EPS)
    return (y * w.astype(jnp.float32)).astype(x.dtype)


def swiglu(h, w_gate, w_up, w_down):
    return (jax.nn.silu(h @ w_gate) * (h @ w_up)) @ w_down


def hgrn2_chunkwise(q, f_logit, i_val, lb):
    bsz, seq, heads, dh = q.shape
    n_chunks = seq // CHUNK
    lb = lb.reshape(heads, dh)
    f = lb + (1.0 - lb) * jax.nn.sigmoid(f_logit)
    log_f = jnp.log(f)
    k = (1.0 - lb) * jax.nn.sigmoid(-f_logit)

    def to_chunks(t):
        return t.reshape(bsz, n_chunks, CHUNK, heads, dh).transpose(1, 0, 3, 2, 4)

    q_c, k_c, v_c, lf_c = to_chunks(q), to_chunks(k), to_chunks(i_val), to_chunks(log_f)
    b = jnp.cumsum(lf_c, axis=3)
    b_last = b[:, :, :, -1:, :]
    q_dec = q_c * jnp.exp(b)
    k_dec = k_c * jnp.exp(-b)
    k_state = k_c * jnp.exp(b_last - b)
    chunk_decay = jnp.exp(b_last[:, :, :, 0, :])

    causal = jnp.tril(jnp.ones((CHUNK, CHUNK), dtype=bool))
    scores = jnp.einsum('nbhck,nbhsk->nbhcs', q_dec, k_dec)
    scores = jnp.where(causal, scores, 0.0)
    o_intra = jnp.einsum('nbhcs,nbhsv->nbhcv', scores, v_c)

    def step(state, inp):
        q_n, k_n, v_n, d_n = inp
        o_n = jnp.einsum('bhck,bhkv->bhcv', q_n, state)
        state = state * d_n[..., None] + jnp.einsum('bhck,bhcv->bhkv', k_n, v_n)
        return state, o_n

    state0 = jnp.zeros((bsz, heads, dh, dh), jnp.float32)
    _, o_inter = lax.scan(step, state0, (q_dec, k_state, v_c, chunk_decay))
    o = o_intra + o_inter
    return o.transpose(1, 0, 3, 2, 4).reshape(bsz, seq, heads, dh)


def causal_depthwise_conv(u, w):
    ch = u.shape[-1]
    rhs = w.reshape(CONV_K, 1, ch).astype(u.dtype)
    return lax.conv_general_dilated(u, rhs, window_strides=(1,), padding=[(CONV_K - 1, 0)],
                                    dimension_numbers=('NWC', 'WIO', 'NWC'), feature_group_count=ch)


def hybrid_mixer(h, w_in, lb, out_norm_w, conv_w, w_out):
    bsz, seq, _ = h.shape
    proj = h @ w_in
    W, C = HGRN_WIDTH, CONV_CH
    q, f_logit, i_val, gate, conv_b, conv_c, conv_h = jnp.split(
        proj, [W, 2 * W, 3 * W, 4 * W, 4 * W + C, 4 * W + 2 * C], axis=-1)

    hs = (bsz, seq, HGRN_HEADS, HGRN_HEAD_DIM)
    o = hgrn2_chunkwise(q.astype(jnp.float32).reshape(hs), f_logit.astype(jnp.float32).reshape(hs),
                        i_val.astype(jnp.float32).reshape(hs), lb)
    o = o * lax.rsqrt(jnp.mean(o * o, axis=-1, keepdims=True) + RMS_EPS)
    o = o * out_norm_w.astype(jnp.float32).reshape(HGRN_HEADS, HGRN_HEAD_DIM)
    o_a = (o.reshape(bsz, seq, W) * jax.nn.silu(gate.astype(jnp.float32))).astype(h.dtype)

    o_b = conv_b * causal_depthwise_conv(conv_c * conv_h, conv_w)

    return jnp.concatenate([o_a, o_b], axis=-1) @ w_out


def setup_inputs(seed: int = 0) -> dict:
    key = jax.random.key(seed)
    ks = jax.random.split(key, 17)
    f32 = jnp.float32

    def dense(k, shape, fan_in):
        return jax.random.normal(k, shape, f32) * (fan_in ** -0.5)

    def gain(k, shape):
        return 1.0 + 0.02 * jax.random.normal(k, shape, f32)

    return {
        "x": jax.random.normal(ks[0], (BATCH, SEQ, D_MODEL), f32),
        "ffn1_norm_w": gain(ks[1], (DEPTH, D_MODEL)),
        "ffn1_w_gate": dense(ks[2], (DEPTH, D_MODEL, D_FF), D_MODEL),
        "ffn1_w_up": dense(ks[3], (DEPTH, D_MODEL, D_FF), D_MODEL),
        "ffn1_w_down": dense(ks[4], (DEPTH, D_FF, D_MODEL), D_FF),
        "mix_norm_w": gain(ks[5], (DEPTH, D_MODEL)),
        "w_in_mix": dense(ks[6], (DEPTH, D_MODEL, IN_COLS), D_MODEL),
        "hgrn_lb_logits": 0.1 * jax.random.normal(ks[7], (DEPTH + 1, HGRN_WIDTH), f32),
        "hgrn_out_norm_w": gain(ks[8], (DEPTH, HGRN_WIDTH)),
        "conv_w": dense(ks[9], (DEPTH, CONV_K, CONV_CH), CONV_K),
        "w_out_mix": dense(ks[10], (DEPTH, D_MIX, D_MODEL), D_MIX),
        "ffn2_norm_w": gain(ks[11], (DEPTH, D_MODEL)),
        "ffn2_w_gate": dense(ks[12], (DEPTH, D_MODEL, D_FF), D_MODEL),
        "ffn2_w_up": dense(ks[13], (DEPTH, D_MODEL, D_FF), D_MODEL),
        "ffn2_w_down": dense(ks[14], (DEPTH, D_FF, D_MODEL), D_FF),
        "final_norm_w": gain(ks[15], (D_MODEL,)),
    }


def reference(x, ffn1_norm_w, ffn1_w_gate, ffn1_w_up, ffn1_w_down, mix_norm_w, w_in_mix,
              hgrn_lb_logits, hgrn_out_norm_w, conv_w, w_out_mix, ffn2_norm_w, ffn2_w_gate,
              ffn2_w_up, ffn2_w_down, final_norm_w):
    lower_bounds = jnp.cumsum(jax.nn.softmax(hgrn_lb_logits.astype(jnp.float32), axis=0), axis=0)
    for l in range(DEPTH):
        x = x + FFN_RESIDUAL_SCALE * swiglu(rmsnorm(x, ffn1_norm_w[l]),
                                            ffn1_w_gate[l], ffn1_w_up[l], ffn1_w_down[l])
        x = x + hybrid_mixer(rmsnorm(x, mix_norm_w[l]), w_in_mix[l], lower_bounds[l],
                             hgrn_out_norm_w[l], conv_w[l], w_out_mix[l])
        x = x + FFN_RESIDUAL_SCALE * swiglu(rmsnorm(x, ffn2_norm_w[l]),
                                            ffn2_w_gate[l], ffn2_w_up[l], ffn2_w_down[l])
    return rmsnorm(x, final_norm_w)
```

```cpp
#include <hip/hip_runtime.h>
#include <hip/hip_cooperative_groups.h>
#include <cstdio>
#include <cstdint>
namespace cg = cooperative_groups;

#define LAS __attribute__((address_space(3)))
typedef unsigned short bf16_t;
typedef short bf16x8 __attribute__((ext_vector_type(8)));
typedef float f32x4 __attribute__((ext_vector_type(4)));
typedef float f32x2 __attribute__((ext_vector_type(2)));
typedef unsigned u32x4 __attribute__((ext_vector_type(4)));
typedef unsigned u32x2 __attribute__((ext_vector_type(2)));

constexpr int D = 2048, M = 16384, SEQ = 2048, FF = 5632, HW = 1024, NHEAD = 8, HD = 128, INC = 7168;
constexpr float EPS = 1e-6f;
constexpr size_t MiB = 1u << 20;
constexpr size_t WS_SSQ = 0;
constexpr size_t WS_BAR = 1 * MiB, BAR_BYTES = 16384;
constexpr size_t WS_SSQH = 2 * MiB;
constexpr size_t WS_W1GU = 4 * MiB, WS_W1D = 48 * MiB, WS_WIN = 70 * MiB, WS_WOUT = 98 * MiB, WS_W2GU = 106 * MiB, WS_W2D = 150 * MiB;
constexpr size_t WS_MIX = 4 * MiB;
constexpr size_t WS_XB = 172 * MiB;
constexpr size_t WS_BIG = 236 * MiB;
constexpr size_t WS_TG = 460 * MiB;
constexpr size_t WS_CUM = 476 * MiB;
constexpr size_t WS_DSEG = 477 * MiB;
constexpr size_t WS_END = 478 * MiB;
constexpr int LDS_BYTES = 147456, LDS_CTL = 131072;

__device__ __forceinline__ unsigned f2bf(float f) { unsigned u = __builtin_bit_cast(unsigned, f); return (u + 0x7fffu + ((u >> 16) & 1u)) >> 16; }
__device__ __forceinline__ unsigned pk2(float lo, float hi) { return f2bf(lo) | (f2bf(hi) << 16); }
__device__ __forceinline__ float bf_lo(unsigned w) { return __builtin_bit_cast(float, w << 16); }
__device__ __forceinline__ float bf_hi(unsigned w) { return __builtin_bit_cast(float, w & 0xffff0000u); }
__device__ __forceinline__ float sigmoidf_(float x) { return __builtin_amdgcn_rcpf(1.0f + __builtin_amdgcn_exp2f(-1.4426950408889634f * x)); }
__device__ __forceinline__ float siluf_(float x) { return x * sigmoidf_(x); }

namespace pg8 {
constexpr int BM = 256, BK = 64, HALF = 128, HTB = HALF * BK * 2, STAGE_BYTES = 8 * HTB, NXCD = 8, WGM = 4;
__host__ __device__ __forceinline__ int lds_byte(int r, int c) { const int st = (r >> 4) * 2 + (c >> 5), rr = r & 15, cc = c & 31, ob = rr * 64 + cc * 2; return st * 1024 + (ob ^ (((ob >> 9) & 1) << 5)); }
__host__ __device__ __forceinline__ void stage_rc(int b, int& R, int& C) { const int st = b / 1024, sb = b % 1024, swz = sb ^ (((sb >> 9) & 1) << 5); R = (st >> 1) * 16 + swz / 64; C = (st & 1) * 32 + (swz % 64) / 2; }
__host__ __device__ __forceinline__ int perm32(int rho) { const int n = rho >> 4, i = rho & 15; return 8 * (i >> 2) + 4 * n + (i & 3); }

struct Unit { int pm, pn; };
struct Gemm { const bf16_t* A; const bf16_t* Bt; int M, N, K; };

struct StaticOrder {
    int nM, nN, nwg, G, c;
    __host__ __device__ void init(int M_, int N_, int G_, int c_) { nM = M_ / BM; nN = N_ / BM; nwg = nM * nN; G = G_; c = c_; }
    __host__ __device__ bool next(int i, Unit& u) const {
        const long L = (long)i * G + c; if (L >= nwg) return false;
        int wgid = (int)L; { const int q = nwg / NXCD, r = nwg % NXCD, xcd = wgid % NXCD, off = wgid / NXCD; wgid = (xcd < r ? xcd * (q + 1) : r * (q + 1) + (xcd - r) * q) + off; }
        const int nig = WGM * nN, gid = wgid / nig, fm = gid * WGM, gsz = (nM - fm) < WGM ? (nM - fm) : WGM;
        u.pm = fm + ((wgid % nig) % gsz); u.pn = (wgid % nig) / gsz; return true;
    }
};

typedef __bf16 bf16x2_t __attribute__((ext_vector_type(2)));
__device__ __forceinline__ unsigned cvt_pk_bf16(float lo, float hi) { const f32x2 v = {lo, hi}; const bf16x2_t b = __builtin_convertvector(v, bf16x2_t); return __builtin_bit_cast(unsigned, b); }

struct EpiSwiGLU {
    static constexpr bool PERM = true;
    bf16_t* O; const float* ssq;
    __device__ __forceinline__ void operator()(const f32x4 (&acc)[2][2][4][2], const Unit& u, int wr, int wc, int fr, int fq) const {
        const int row0 = u.pm * BM + wr * 64 + fr, col0 = u.pn * HALF + wc * 32 + 8 * fq;
        float rsv[2][4];
#pragma unroll
        for (int ai = 0; ai < 2; ++ai)
#pragma unroll
            for (int m = 0; m < 4; ++m) rsv[ai][m] = ssq[row0 + ai * HALF + m * 16];
        __builtin_amdgcn_sched_barrier(0);
#pragma unroll
        for (int ai = 0; ai < 2; ++ai)
#pragma unroll
            for (int m = 0; m < 4; ++m) {
                const int row = row0 + ai * HALF + m * 16;
                const float rs = __builtin_amdgcn_rsqf(rsv[ai][m] * (1.0f / D) + EPS);
                f32x4 h0, h1;
#pragma unroll
                for (int j = 0; j < 4; ++j) { h0[j] = siluf_(acc[ai][0][m][0][j] * rs) * (acc[ai][1][m][0][j] * rs); h1[j] = siluf_(acc[ai][0][m][1][j] * rs) * (acc[ai][1][m][1][j] * rs); }
                u32x4 w; w.x = cvt_pk_bf16(h0[0], h0[1]); w.y = cvt_pk_bf16(h0[2], h0[3]); w.z = cvt_pk_bf16(h1[0], h1[1]); w.w = cvt_pk_bf16(h1[2], h1[3]);
                *(u32x4*)(O + (size_t)row * FF + col0) = w;
            }
    }
};
struct EpiProj {
    static constexpr bool PERM = true;
    bf16_t* O; const float* ssq;
    __device__ __forceinline__ void operator()(const f32x4 (&acc)[2][2][4][2], const Unit& u, int wr, int wc, int fr, int fq) const {
        const int row0 = u.pm * BM + wr * 64 + fr, col0 = u.pn * BM + wc * 32 + 8 * fq;
        float rsv[2][4];
#pragma unroll
        for (int ai = 0; ai < 2; ++ai)
#pragma unroll
            for (int m = 0; m < 4; ++m) rsv[ai][m] = ssq[row0 + ai * HALF + m * 16];
        __builtin_amdgcn_sched_barrier(0);
#pragma unroll
        for (int ai = 0; ai < 2; ++ai)
#pragma unroll
            for (int m = 0; m < 4; ++m) {
                const int row = row0 + ai * HALF + m * 16;
                const float rs = __builtin_amdgcn_rsqf(rsv[ai][m] * (1.0f / D) + EPS);
                if (u.pn >= 20) {
                    const float rs2 = rs * rs;
                    const f32x4 v0 = acc[ai][0][m][0] * acc[ai][1][m][0] * rs2, v1 = acc[ai][0][m][1] * acc[ai][1][m][1] * rs2;
                    u32x4 w; w.x = cvt_pk_bf16(v0[0], v0[1]); w.y = cvt_pk_bf16(v0[2], v0[3]); w.z = cvt_pk_bf16(v1[0], v1[1]); w.w = cvt_pk_bf16(v1[2], v1[3]);
                    *(u32x4*)(O + (size_t)row * INC + 5 * HW + (u.pn - 20) * HALF + wc * 32 + 8 * fq) = w;
                } else {
#pragma unroll
                for (int bj = 0; bj < 2; ++bj) { const f32x4 v0 = acc[ai][bj][m][0] * rs, v1 = acc[ai][bj][m][1] * rs;
                    u32x4 w; w.x = cvt_pk_bf16(v0[0], v0[1]); w.y = cvt_pk_bf16(v0[2], v0[3]); w.z = cvt_pk_bf16(v1[0], v1[1]); w.w = cvt_pk_bf16(v1[2], v1[3]);
                    *(u32x4*)(O + (size_t)row * INC + col0 + bj * HALF) = w; }
                }
            }
    }
};
template <bool BASE_BF, bool OUT_BF> struct EpiResid {
    static constexpr bool PERM = true;
    const float* basef; const bf16_t* baseb; float* outf; bf16_t* outb; float* ssq; float scale;
    __device__ __forceinline__ void operator()(const f32x4 (&acc)[2][2][4][2], const Unit& u, int wr, int wc, int fr, int fq) const {
        const int row0 = u.pm * BM + wr * 64 + fr, col0 = u.pn * BM + wc * 32 + 8 * fq;
#pragma unroll
        for (int ai = 0; ai < 2; ++ai) {
            f32x4 b[4][2][2];
#pragma unroll
            for (int m = 0; m < 4; ++m) { const size_t off = (size_t)(row0 + ai * HALF + m * 16) * D + col0;
#pragma unroll
                for (int bj = 0; bj < 2; ++bj) {
                    if (BASE_BF) { const u32x4 w = *(const u32x4*)(baseb + off + bj * HALF);
                        b[m][bj][0] = (f32x4){bf_lo(w.x), bf_hi(w.x), bf_lo(w.y), bf_hi(w.y)}; b[m][bj][1] = (f32x4){bf_lo(w.z), bf_hi(w.z), bf_lo(w.w), bf_hi(w.w)}; }
                    else { b[m][bj][0] = *(const f32x4*)(basef + off + bj * HALF); b[m][bj][1] = *(const f32x4*)(basef + off + bj * HALF + 4); } } }
            __builtin_amdgcn_sched_barrier(0);
#pragma unroll
            for (int m = 0; m < 4; ++m) {
                const int row = row0 + ai * HALF + m * 16; const size_t off = (size_t)row * D + col0; float s = 0.f;
#pragma unroll
                for (int bj = 0; bj < 2; ++bj) {
                    const f32x4 v0 = b[m][bj][0] + acc[ai][bj][m][0] * scale, v1 = b[m][bj][1] + acc[ai][bj][m][1] * scale;
                    s += ((v0[0] * v0[0] + v0[1] * v0[1]) + (v0[2] * v0[2] + v0[3] * v0[3])) + ((v1[0] * v1[0] + v1[1] * v1[1]) + (v1[2] * v1[2] + v1[3] * v1[3]));
                    if (OUT_BF) { u32x4 w; w.x = cvt_pk_bf16(v0[0], v0[1]); w.y = cvt_pk_bf16(v0[2], v0[3]); w.z = cvt_pk_bf16(v1[0], v1[1]); w.w = cvt_pk_bf16(v1[2], v1[3]); *(u32x4*)(outb + off + bj * HALF) = w; }
                    else { *(f32x4*)(outf + off + bj * HALF) = v0; *(f32x4*)(outf + off + bj * HALF + 4) = v1; }
                }
                s += __shfl_xor(s, 16); s += __shfl_xor(s, 32);
                if (fq == 0) (void)__hip_atomic_fetch_add(ssq + row, s, __ATOMIC_RELAXED, __HIP_MEMORY_SCOPE_AGENT);
            }
            asm volatile("" ::: "memory");
        }
    }
};

template <class Epi, bool ALIGN_EPI = true, bool SP2 = true>
__device__ __forceinline__ void gemm_phase(LAS unsigned char* lds, const Gemm g, const StaticOrder& S, const Epi& E) {
    int tid = threadIdx.x; asm volatile("" : "+v"(tid));
    const int wid = __builtin_amdgcn_readfirstlane(tid >> 6), lane = tid & 63, wr = wid >> 2, wc = wid & 3, fr = lane & 15, fq = lane >> 4;
    const int K = g.K, nt = K / BK;
    unsigned voffA[2], voffB[2];
#pragma unroll
    for (int i = 0; i < 2; ++i) { int R, C; stage_rc(tid * 16 + i * 8192, R, C); const int Rb = Epi::PERM ? ((R & ~31) + perm32(R & 31)) : R;
        voffA[i] = (unsigned)(R * K + C) * 2u; voffB[i] = (unsigned)(Rb * K + C) * 2u; }
    const size_t kstep = (size_t)(BK * 2);
    const size_t hstep = (size_t)HALF * K * 2;
    const size_t tstep = 2 * hstep;
    const unsigned ldsw = (unsigned)wid * 1024u;
    const int aoff = lds_byte(wr * 64 + fr, fq * 8), boff = lds_byte(wc * 32 + fr, fq * 8);
#define PG8_SA(b, h) (((b) * 2 + (h)) * HTB)
#define PG8_SB(b, h) ((4 + (b) * 2 + (h)) * HTB)
#define PG8_STAGE(bufoff, gbase, voff) do { _Pragma("unroll") for (int _i = 0; _i < 2; ++_i) \
        __builtin_amdgcn_global_load_lds((const unsigned*)((const char*)(gbase) + (voff)[_i]), (LAS unsigned*)(lds + (bufoff) + ldsw + _i * 8192), 16, 0, 0); } while (0)
#define PG8_LDA(dst, b, h) do { _Pragma("unroll") for (int m = 0; m < 4; ++m) _Pragma("unroll") for (int k = 0; k < 2; ++k) dst[m][k] = *(const LAS bf16x8*)(lds + PG8_SA(b, h) + aoff + m * 2048 + k * 1024); } while (0)
#define PG8_LDB(dst, b, h) do { _Pragma("unroll") for (int n = 0; n < 2; ++n) _Pragma("unroll") for (int k = 0; k < 2; ++k) dst[n][k] = *(const LAS bf16x8*)(lds + PG8_SB(b, h) + boff + n * 2048 + k * 1024); } while (0)
#define PG8_MMA(ai, bj, At, Bt) do { __builtin_amdgcn_s_setprio(1); _Pragma("unroll") for (int m = 0; m < 4; ++m) _Pragma("unroll") for (int n = 0; n < 2; ++n) _Pragma("unroll") for (int k = 0; k < 2; ++k) \
        acc[ai][bj][m][n] = __builtin_amdgcn_mfma_f32_16x16x32_bf16(Bt[n][k], At[m][k], acc[ai][bj][m][n], 0, 0, 0); __builtin_amdgcn_s_setprio(0); } while (0)
#define PG8_WAIT_V(n) asm volatile("s_waitcnt vmcnt(" #n ")" ::: "memory")
#define PG8_WAIT_L(n) asm volatile("s_waitcnt lgkmcnt(" #n ")" ::: "memory")
#define PG8_BAR __builtin_amdgcn_s_barrier()
#define PG8_SCHED __builtin_amdgcn_sched_barrier(0)
    Unit cur, nxt; int ui = 0;
    if (!S.next(0, cur)) return;
    f32x4 acc[2][2][4][2];
#pragma unroll
    for (int a = 0; a < 2; ++a)
#pragma unroll
        for (int b = 0; b < 2; ++b)
#pragma unroll
            for (int m = 0; m < 4; ++m)
#pragma unroll
                for (int n = 0; n < 2; ++n) acc[a][b][m][n] = (f32x4){0.f, 0.f, 0.f, 0.f};
    bf16x8 At[4][2], B0[2][2], B1[2][2];
    const char* cA = (const char*)g.A + (size_t)cur.pm * tstep; const char* cB = (const char*)g.Bt + (size_t)cur.pn * tstep;
    if constexpr (SP2) {
        PG8_STAGE(PG8_SB(0, 0), cB, voffB); PG8_STAGE(PG8_SB(0, 1), cB + hstep, voffB); PG8_STAGE(PG8_SA(0, 0), cA, voffA); PG8_STAGE(PG8_SA(0, 1), cA + hstep, voffA);
        if (wr == 1) PG8_BAR;
        PG8_WAIT_V(2); PG8_BAR;
        PG8_STAGE(PG8_SB(1, 0), cB + kstep, voffB); PG8_STAGE(PG8_SA(1, 0), cA + kstep, voffA); PG8_STAGE(PG8_SB(1, 1), cB + hstep + kstep, voffB);
        PG8_WAIT_V(6); PG8_BAR;
    } else {
        PG8_STAGE(PG8_SB(0, 0), cB, voffB); PG8_STAGE(PG8_SA(0, 0), cA, voffA); PG8_STAGE(PG8_SB(0, 1), cB + hstep, voffB); PG8_STAGE(PG8_SA(0, 1), cA + hstep, voffA);
        if (wr == 1) PG8_BAR;
        PG8_WAIT_V(4); PG8_BAR;
        PG8_STAGE(PG8_SB(1, 0), cB + kstep, voffB); PG8_STAGE(PG8_SA(1, 0), cA + kstep, voffA); PG8_STAGE(PG8_SB(1, 1), cB + hstep + kstep, voffB);
        PG8_WAIT_V(6); PG8_BAR;
    }
    for (;;) {
        const bool has_next = S.next(ui + 1, nxt);
        const char* nA = has_next ? (const char*)g.A + (size_t)nxt.pm * tstep : cA; const char* nB = has_next ? (const char*)g.Bt + (size_t)nxt.pn * tstep : cB;
        for (int t = 0; t < nt; t += 2) {
            const bool last = (t == nt - 2);
            const char* a1 = cA + (size_t)(t + 1) * kstep;
            const char* a2 = last ? nA : cA + (size_t)(t + 2) * kstep; const char* b2 = last ? nB : cB + (size_t)(t + 2) * kstep;
            const char* a3 = a2 + kstep; const char* b3 = b2 + kstep;
            if constexpr (SP2) {
            PG8_LDB(B0, 0, 0); PG8_LDB(B1, 0, 1); PG8_SCHED; PG8_LDA(At, 0, 0); PG8_STAGE(PG8_SA(1, 1), a1 + hstep, voffA);
            PG8_WAIT_V(8); PG8_WAIT_L(0); PG8_BAR; PG8_MMA(0, 0, At, B0); PG8_MMA(0, 1, At, B1); PG8_BAR; PG8_SCHED;
            PG8_LDA(At, 0, 1); PG8_STAGE(PG8_SB(0, 0), b2, voffB); PG8_STAGE(PG8_SB(0, 1), b2 + hstep, voffB); PG8_STAGE(PG8_SA(0, 0), a2, voffA);
            PG8_WAIT_V(8); PG8_WAIT_L(0); PG8_BAR; PG8_MMA(1, 0, At, B0); PG8_MMA(1, 1, At, B1); PG8_BAR; PG8_SCHED;
            PG8_LDB(B0, 1, 0); PG8_LDB(B1, 1, 1); PG8_SCHED; PG8_LDA(At, 1, 0); PG8_STAGE(PG8_SA(0, 1), a2 + hstep, voffA);
            PG8_WAIT_V(8); PG8_WAIT_L(0); PG8_BAR; PG8_MMA(0, 0, At, B0); PG8_MMA(0, 1, At, B1); PG8_BAR; PG8_SCHED;
            PG8_LDA(At, 1, 1); PG8_STAGE(PG8_SB(1, 0), b3, voffB); PG8_STAGE(PG8_SB(1, 1), b3 + hstep, voffB); PG8_STAGE(PG8_SA(1, 0), a3, voffA);
            PG8_WAIT_V(8); PG8_WAIT_L(0); PG8_BAR; PG8_MMA(1, 0, At, B0); PG8_MMA(1, 1, At, B1); PG8_BAR; PG8_SCHED;
            } else {
            PG8_LDB(B0, 0, 0); PG8_SCHED; PG8_LDA(At, 0, 0); PG8_STAGE(PG8_SA(1, 1), a1 + hstep, voffA);
            PG8_WAIT_L(8); PG8_BAR; PG8_WAIT_L(0); PG8_MMA(0, 0, At, B0); PG8_BAR; PG8_SCHED;
            PG8_LDB(B1, 0, 1); PG8_STAGE(PG8_SB(0, 0), b2, voffB);
            PG8_BAR; PG8_WAIT_L(0); PG8_MMA(0, 1, At, B1); PG8_BAR;
            PG8_LDA(At, 0, 1); PG8_STAGE(PG8_SA(0, 0), a2, voffA);
            PG8_BAR; PG8_WAIT_L(0); PG8_MMA(1, 0, At, B0); PG8_BAR; PG8_SCHED;
            PG8_STAGE(PG8_SB(0, 1), b2 + hstep, voffB);
            PG8_WAIT_V(6); PG8_BAR; PG8_MMA(1, 1, At, B1); PG8_BAR;
            PG8_LDB(B0, 1, 0); PG8_SCHED; PG8_LDA(At, 1, 0); PG8_STAGE(PG8_SA(0, 1), a2 + hstep, voffA);
            PG8_WAIT_L(8); PG8_BAR; PG8_WAIT_L(0); PG8_MMA(0, 0, At, B0); PG8_BAR; PG8_SCHED;
            PG8_LDB(B1, 1, 1); PG8_STAGE(PG8_SB(1, 0), b3, voffB);
            PG8_BAR; PG8_WAIT_L(0); PG8_MMA(0, 1, At, B1); PG8_BAR;
            PG8_LDA(At, 1, 1); PG8_STAGE(PG8_SA(1, 0), a3, voffA);
            PG8_BAR; PG8_WAIT_L(0); PG8_MMA(1, 0, At, B0); PG8_BAR; PG8_SCHED;
            PG8_STAGE(PG8_SB(1, 1), b3 + hstep, voffB);
            PG8_WAIT_V(6); PG8_BAR; PG8_MMA(1, 1, At, B1); PG8_BAR;
            }
        }
        if constexpr (ALIGN_EPI) { if (wr == 0) PG8_BAR; }
        E(acc, cur, wr, wc, fr, fq);
        if (!has_next) break;
#pragma unroll
        for (int a = 0; a < 2; ++a)
#pragma unroll
            for (int b = 0; b < 2; ++b)
#pragma unroll
                for (int m = 0; m < 4; ++m)
#pragma unroll
                    for (int n = 0; n < 2; ++n) acc[a][b][m][n] = (f32x4){0.f, 0.f, 0.f, 0.f};
        cur = nxt; cA = nA; cB = nB; ++ui;
        if constexpr (ALIGN_EPI) { if (wr == 1) PG8_BAR; }
    }
    PG8_WAIT_V(0);
    if constexpr (!ALIGN_EPI) { if (wr == 0) PG8_BAR; }
    PG8_BAR;
#undef PG8_SA
#undef PG8_SB
#undef PG8_STAGE
#undef PG8_LDA
#undef PG8_LDB
#undef PG8_MMA
#undef PG8_WAIT_V
#undef PG8_WAIT_L
#undef PG8_BAR
#undef PG8_SCHED
}
}

#define LDS_WAIT() asm volatile("s_waitcnt lgkmcnt(0)" ::: "memory")
__device__ __forceinline__ float wave_sum(float v) {
#pragma unroll
    for (int o = 1; o < 64; o <<= 1) v += __shfl_xor(v, o);
    return v;
}
struct P0Desc { const float* W; bf16_t* WT; const float* ks; int K, N, mode, item; };
__device__ __forceinline__ void p0_load(const P0Desc& d, f32x4 (&v)[8], float (&sc)[8], int lane) {
    const int nblk = d.N / 32, kb = d.item / nblk, nb = d.item % nblk, k0 = 64 * kb, n0 = 32 * nb, kr = lane >> 3, nc = (lane & 7) * 4;
#pragma unroll
    for (int i = 0; i < 8; ++i) { v[i] = __builtin_nontemporal_load((const f32x4*)(d.W + (size_t)(k0 + kr + 8 * i) * d.N + n0 + nc)); sc[i] = d.ks ? d.ks[k0 + kr + 8 * i] : 1.0f; }
}
__device__ __forceinline__ void p0_finish(const P0Desc& d, const f32x4 (&v)[8], const float (&sc)[8], LAS float* scr, int lane) {
    const int nblk = d.N / 32, kb = d.item / nblk, nb = d.item % nblk, k0 = 64 * kb, n0 = 32 * nb, kr = lane >> 3, nc = (lane & 7) * 4;
#pragma unroll
    for (int i = 0; i < 8; ++i) { LAS float* p = scr + (kr + 8 * i) * 33 + nc; p[0] = v[i][0] * sc[i]; p[1] = v[i][1] * sc[i]; p[2] = v[i][2] * sc[i]; p[3] = v[i][3] * sc[i]; }
    LDS_WAIT(); asm volatile("" ::: "memory");
    const int c = lane & 7;
    int rb;
    if (d.mode == 0) rb = n0;
    else if (d.mode == 3) rb = (n0 < 5 * HW) ? n0 : ((n0 < 6 * HW) ? 5 * HW + (((n0 - 5 * HW) >> 7) * 256) + ((n0 - 5 * HW) & 127) : 5 * HW + (((n0 - 6 * HW) >> 7) * 256) + 128 + ((n0 - 6 * HW) & 127));
    else rb = (n0 >> 7) * 256 + (d.mode == 2 ? 128 : 0) + (n0 & 127);
#pragma unroll
    for (int j = 0; j < 4; ++j) { const int n = (lane >> 3) + 8 * j; const LAS float* sp = scr + (8 * c) * 33 + n;
        u32x4 o; o.x = pk2(sp[0 * 33], sp[1 * 33]); o.y = pk2(sp[2 * 33], sp[3 * 33]); o.z = pk2(sp[4 * 33], sp[5 * 33]); o.w = pk2(sp[6 * 33], sp[7 * 33]);
        *(u32x4*)(d.WT + (size_t)(rb + n) * d.K + k0 + 8 * c) = o; }
    LDS_WAIT(); asm volatile("" ::: "memory");
}


#define XB_TMO      128
#define XB_XCNT(j)  (256  + 64 * (j))
#define XB_XSUB(j)  (1280 + 64 * (j))
#define XB_XGEN(j)  (2304 + 64 * (j))
#define XB_TOP      3328
#define XB_TOPGEN   3392
#define XCD_BAR_WORDS 3456
#define XB_SPIN_CAP (1u << 18)
__device__ __forceinline__ unsigned xb_ld(unsigned* p)              { return __hip_atomic_load(p, __ATOMIC_RELAXED, __HIP_MEMORY_SCOPE_AGENT); }
__device__ __forceinline__ unsigned xb_add(unsigned* p, unsigned v) { return __hip_atomic_fetch_add(p, v, __ATOMIC_RELAXED, __HIP_MEMORY_SCOPE_AGENT); }
__device__ __forceinline__ unsigned xb_xcc_id() { return (unsigned)__builtin_amdgcn_s_getreg((3 << 11) | 20) & 0xFu; }
#define XB_SPIN(cond, bar) do { unsigned _sp = 0; while (cond) { __builtin_amdgcn_s_sleep(1); \
    if ((++_sp & 255u) == 0u) { if (xb_ld(&(bar)[XB_TMO])) break; if (_sp > XB_SPIN_CAP) { atomicAdd(&(bar)[XB_TMO], 1u); break; } } } } while (0)
struct XcdBarrier { unsigned* bar; unsigned x; volatile LAS unsigned* st; };
__device__ __forceinline__ XcdBarrier xcd_barrier_post(unsigned* bar, volatile LAS unsigned* st) {
    XcdBarrier b; b.bar = bar; b.x = xb_xcc_id(); b.st = st;
    if (threadIdx.x == 0) (void)xb_add(&bar[XB_XCNT(b.x)], 1u);
    return b;
}
__device__ __forceinline__ void xcd_barrier_complete(unsigned* bar, unsigned x, unsigned& nloc, unsigned& nx) {
    const unsigned G = gridDim.x * gridDim.y * gridDim.z;
    unsigned sum, cnt, mine, sp = 0u;
    for (;;) {
        sum = 0u; cnt = 0u; mine = 0u;
#pragma unroll
        for (unsigned j = 0; j < 16; ++j) { const unsigned c = xb_ld(&bar[XB_XCNT(j)]); sum += c; cnt += (c > 0u) ? 1u : 0u; mine = (j == x) ? c : mine; }
        if (sum == G) break;
        __builtin_amdgcn_s_sleep(1);
        if ((++sp & 255u) == 0u) { if (xb_ld(&bar[XB_TMO])) break; if (sp > XB_SPIN_CAP) { atomicAdd(&bar[XB_TMO], 1u); break; } }
    }
    nloc = mine > 0u ? mine : 1u; nx = cnt > 0u ? cnt : 1u;
}
__device__ __forceinline__ void xcd_barrier(const XcdBarrier& b) {
    asm volatile("s_waitcnt vmcnt(0)" ::: "memory");
    __syncthreads();
    if (threadIdx.x == 0) {
        unsigned* bar = b.bar;
        __builtin_amdgcn_s_waitcnt(0);
        unsigned nloc = b.st[0], nx = b.st[1];
        if (nloc == 0u) { xcd_barrier_complete(bar, b.x, nloc, nx); b.st[0] = nloc; b.st[1] = nx; }
        const unsigned old = xb_add(&bar[XB_XSUB(b.x)], 1u);
        const unsigned gen = old / nloc;
        if (old + 1u == (gen + 1u) * nloc) {
            __builtin_amdgcn_fence(__ATOMIC_RELEASE, "agent");
            asm volatile("s_waitcnt vmcnt(0)" ::: "memory");
            const unsigned og = xb_add(&bar[XB_TOP], 1u);
            const unsigned tg = og / nx;
            if (og + 1u == (tg + 1u) * nx) xb_add(&bar[XB_TOPGEN], 1u);
            else XB_SPIN(xb_ld(&bar[XB_TOPGEN]) == tg, bar);
            __builtin_amdgcn_fence(__ATOMIC_ACQUIRE, "agent");
            xb_add(&bar[XB_XGEN(b.x)], 1u);
            asm volatile("s_waitcnt vmcnt(0)" ::: "memory");
        } else {
            XB_SPIN(xb_ld(&bar[XB_XGEN(b.x)]) == gen, bar);
            __builtin_amdgcn_fence(__ATOMIC_ACQUIRE, "agent");
            asm volatile("s_waitcnt vmcnt(0)" ::: "memory");
        }
    }
    __syncthreads();
}


__device__ __forceinline__ void hgrn_p1(LAS unsigned char* lds, bf16_t* PROJ, const float* lbl, bf16_t* OLOC, float* TG, float* CUMG, float* DSEG, int item, int tid_in) {
    int tid = tid_in; asm volatile("" : "+v"(tid));
    constexpr int QS = 272, TS = 144;
    LAS unsigned char* Qd = lds;
    LAS unsigned char* Kd = lds + 17408;
    LAS unsigned char* KsT = lds + 34816;
    LAS unsigned char* VT = KsT + 18432;
    LAS unsigned char* ST = VT + 18432;
    LAS unsigned char* Pm = ST + 34816;
    LAS unsigned char* GT = Pm + 9216;
    LAS unsigned char* DEC = GT + 4096;
    const int lane = tid & 63, w = __builtin_amdgcn_readfirstlane(tid >> 6), r = lane & 15, q = lane >> 4;
    const int b = item >> 5, h = (item >> 2) & 7, g = item & 3;
    const size_t row0 = (size_t)b * SEQ + (size_t)g * 512;
    const int kp = lane, tg = w;
    const int ci = w & 3, vh = w >> 2;
    const float lb0 = sigmoidf_(lbl[h * HD + 2 * kp] - lbl[HW + h * HD + 2 * kp]), lb1 = sigmoidf_(lbl[h * HD + 2 * kp + 1] - lbl[HW + h * HD + 2 * kp + 1]);
    __syncthreads();
    for (int i = tid; i < 34816 / 16; i += 512) *(LAS u32x4*)(ST + i * 16) = (u32x4){0u, 0u, 0u, 0u};
    f32x4 accS[8];
#pragma unroll
    for (int i = 0; i < 8; ++i) accS[i] = (f32x4){0.f, 0.f, 0.f, 0.f};
    char* sbase = (char*)(PROJ + (row0 + 8 * tg) * INC + h * HD);
    const unsigned voff = 4u * (unsigned)kp;
    float cum0 = 1.f, cum1 = 1.f;
    float* cumg = CUMG + ((size_t)(b * 8 + h) * 32 + g * 8) * 128 + 2 * kp;
    unsigned rq[8], rf[8], rv[8];
#pragma unroll
    for (int i = 0; i < 8; ++i) { const char* p = sbase + (size_t)i * INC * 2; rq[i] = *(const unsigned*)(p + voff); rf[i] = *(const unsigned*)(p + HW * 2 + voff); rv[i] = *(const unsigned*)(p + 4 * HW + voff); }
    for (int n = 0; n < 8; ++n) {
        f32x2 fv[8], cpv[8]; f32x2 cc = {1.f, 1.f};
        const f32x2 lbv = {lb0, lb1}, omlb = {1.f - lb0, 1.f - lb1};
#pragma unroll
        for (int i = 0; i < 8; ++i) {
            const f32x2 xv = {bf_lo(rf[i]), bf_hi(rf[i])}; const f32x2 tv = xv * (-1.4426950408889634f);
            f32x2 ev; ev.x = __builtin_amdgcn_exp2f(tv.x); ev.y = __builtin_amdgcn_exp2f(tv.y);
            const f32x2 dv = ev + 1.0f; f32x2 sv; sv.x = __builtin_amdgcn_rcpf(dv.x); sv.y = __builtin_amdgcn_rcpf(dv.y);
            fv[i] = lbv + omlb * sv; cc = cc * fv[i]; cpv[i] = cc;
        }
        *(LAS f32x2*)(GT + (tg * 128 + 2 * kp) * 4) = cc;
        __syncthreads();
        f32x2 prev = {1.f, 1.f}, totv = {1.f, 1.f};
#pragma unroll
        for (int gg = 0; gg < 8; ++gg) { const f32x2 gv = *(const LAS f32x2*)(GT + (gg * 128 + 2 * kp) * 4); if (gg < tg) prev = prev * gv; totv = totv * gv; }
        {
            f32x2 rP[8];
            {   const f32x2 p7 = prev * cpv[7]; rP[7].x = __builtin_amdgcn_rcpf(fmaxf(p7.x, 1e-30f)); rP[7].y = __builtin_amdgcn_rcpf(fmaxf(p7.y, 1e-30f)); }
#pragma unroll
            for (int i = 6; i >= 0; --i) rP[i] = rP[i + 1] * fv[i + 1];
            f32x2 ksv[8];
#pragma unroll
            for (int i = 0; i < 8; ++i) {
                const f32x2 Pv = prev * cpv[i];
                const f32x2 kd = (1.0f - fv[i]) * rP[i];
                const f32x2 qv = {bf_lo(rq[i]), bf_hi(rq[i])}; const f32x2 qdv = qv * Pv;
                const int t = 8 * tg + i;
                const unsigned qd = pg8::cvt_pk_bf16(qdv.x, qdv.y);
                *(LAS unsigned*)(Qd + t * QS + 4 * kp) = qd;
                *(unsigned*)(sbase + (size_t)(n * 64 + i) * INC * 2 + voff) = qd;
                *(LAS unsigned*)(Kd + t * QS + 4 * kp) = pg8::cvt_pk_bf16(kd.x, kd.y);
                ksv[i] = kd * totv;
            }
            u32x4 a0, a1, v0, v1;
            a0.x = pg8::cvt_pk_bf16(ksv[0].x, ksv[1].x); a0.y = pg8::cvt_pk_bf16(ksv[2].x, ksv[3].x); a0.z = pg8::cvt_pk_bf16(ksv[4].x, ksv[5].x); a0.w = pg8::cvt_pk_bf16(ksv[6].x, ksv[7].x);
            a1.x = pg8::cvt_pk_bf16(ksv[0].y, ksv[1].y); a1.y = pg8::cvt_pk_bf16(ksv[2].y, ksv[3].y); a1.z = pg8::cvt_pk_bf16(ksv[4].y, ksv[5].y); a1.w = pg8::cvt_pk_bf16(ksv[6].y, ksv[7].y);
            v0.x = (rv[0] & 0xffffu) | (rv[1] << 16); v0.y = (rv[2] & 0xffffu) | (rv[3] << 16); v0.z = (rv[4] & 0xffffu) | (rv[5] << 16); v0.w = (rv[6] & 0xffffu) | (rv[7] << 16);
            v1.x = (rv[0] >> 16) | (rv[1] & 0xffff0000u); v1.y = (rv[2] >> 16) | (rv[3] & 0xffff0000u); v1.z = (rv[4] >> 16) | (rv[5] & 0xffff0000u); v1.w = (rv[6] >> 16) | (rv[7] & 0xffff0000u);
            *(LAS u32x4*)(KsT + (2 * kp) * TS + 16 * tg) = a0; *(LAS u32x4*)(KsT + (2 * kp + 1) * TS + 16 * tg) = a1;
            *(LAS u32x4*)(VT + (2 * kp) * TS + 16 * tg) = v0; *(LAS u32x4*)(VT + (2 * kp + 1) * TS + 16 * tg) = v1;
            if (tg == 0) { *(LAS f32x2*)(DEC + 8 * kp) = totv; *(f32x2*)(cumg + n * 128) = (f32x2){cum0, cum1}; }
            cum0 *= totv.x; cum1 *= totv.y;
        }
        __syncthreads();
        if (n + 1 < 8) {
#pragma unroll
            for (int i = 0; i < 8; ++i) { const char* p = sbase + (size_t)((n + 1) * 64 + i) * INC * 2; rq[i] = *(const unsigned*)(p + voff); rf[i] = *(const unsigned*)(p + HW * 2 + voff); rv[i] = *(const unsigned*)(p + 4 * HW + voff); }
        }
        {
            const int si = w & 3, c20 = 2 * (w >> 2);
            bf16x8 av[4], b0[4], b1[4];
            if (si <= c20 + 1) {
#pragma unroll
                for (int kk = 0; kk < 4; ++kk) { av[kk] = *(const LAS bf16x8*)(Kd + (16 * si + r) * QS + (32 * kk + 8 * q) * 2);
                    b0[kk] = *(const LAS bf16x8*)(Qd + (16 * c20 + r) * QS + (32 * kk + 8 * q) * 2); b1[kk] = *(const LAS bf16x8*)(Qd + (16 * (c20 + 1) + r) * QS + (32 * kk + 8 * q) * 2); }
            }
            __builtin_amdgcn_sched_barrier(0);
            f32x4 acc0 = (f32x4){0.f, 0.f, 0.f, 0.f}, acc1 = (f32x4){0.f, 0.f, 0.f, 0.f};
            if (si <= c20 + 1) {
#pragma unroll
                for (int kk = 0; kk < 4; ++kk) { acc0 = __builtin_amdgcn_mfma_f32_16x16x32_bf16(av[kk], b0[kk], acc0, 0, 0, 0); acc1 = __builtin_amdgcn_mfma_f32_16x16x32_bf16(av[kk], b1[kk], acc1, 0, 0, 0); }
            }
#pragma unroll
            for (int j = 0; j < 4; ++j) { if (si > c20 || (si == c20 && 4 * q + j > r)) acc0[j] = 0.f; if (si == c20 + 1 && 4 * q + j > r) acc1[j] = 0.f; }
            u32x2 pw; pw.x = pg8::cvt_pk_bf16(acc0[0], acc0[1]); pw.y = pg8::cvt_pk_bf16(acc0[2], acc0[3]);
            *(LAS u32x2*)(Pm + (16 * c20 + r) * TS + (16 * si + 4 * q) * 2) = pw;
            pw.x = pg8::cvt_pk_bf16(acc1[0], acc1[1]); pw.y = pg8::cvt_pk_bf16(acc1[2], acc1[3]);
            *(LAS u32x2*)(Pm + (16 * (c20 + 1) + r) * TS + (16 * si + 4 * q) * 2) = pw;
        }
        __syncthreads();
        {
            bf16x8 pa[2], qa[4], bb[6];
#pragma unroll
            for (int kk = 0; kk < 2; ++kk) pa[kk] = *(const LAS bf16x8*)(Pm + (16 * ci + r) * TS + (32 * kk + 8 * q) * 2);
#pragma unroll
            for (int kk = 0; kk < 4; ++kk) qa[kk] = *(const LAS bf16x8*)(Qd + (16 * ci + r) * QS + (32 * kk + 8 * q) * 2);
            bf16_t* op = OLOC + (row0 + (size_t)n * 64 + 16 * ci + r) * HW + h * HD + 64 * vh + 4 * q;
#pragma unroll
            for (int i = 0; i < 4; ++i) {
                const int vt = 4 * vh + i;
#pragma unroll
                for (int kk = 0; kk < 2; ++kk) bb[kk] = *(const LAS bf16x8*)(VT + (16 * vt + r) * TS + (32 * kk + 8 * q) * 2);
#pragma unroll
                for (int kk = 0; kk < 4; ++kk) bb[2 + kk] = *(const LAS bf16x8*)(ST + (16 * vt + r) * QS + (32 * kk + 8 * q) * 2);
                __builtin_amdgcn_sched_barrier(0);
                f32x4 acc = (f32x4){0.f, 0.f, 0.f, 0.f};
#pragma unroll
                for (int kk = 0; kk < 2; ++kk) acc = __builtin_amdgcn_mfma_f32_16x16x32_bf16(bb[kk], pa[kk], acc, 0, 0, 0);
#pragma unroll
                for (int kk = 0; kk < 4; ++kk) acc = __builtin_amdgcn_mfma_f32_16x16x32_bf16(bb[2 + kk], qa[kk], acc, 0, 0, 0);
                { u32x2 ow; ow.x = pg8::cvt_pk_bf16(acc[0], acc[1]); ow.y = pg8::cvt_pk_bf16(acc[2], acc[3]); *(u32x2*)(op + 16 * i) = ow; }
                __builtin_amdgcn_sched_barrier(0);
            }
        }
        __syncthreads();
        {
            const f32x4 dkc = *(const LAS f32x4*)(DEC + (16 * w + 4 * q) * 4);
            bf16x8 ka[2], vb[8];
#pragma unroll
            for (int kk = 0; kk < 2; ++kk) ka[kk] = *(const LAS bf16x8*)(KsT + (16 * w + r) * TS + (32 * kk + 8 * q) * 2);
#pragma unroll
            for (int hf = 0; hf < 2; ++hf) {
#pragma unroll
                for (int t4 = 0; t4 < 4; ++t4)
#pragma unroll
                    for (int kk = 0; kk < 2; ++kk) vb[2 * t4 + kk] = *(const LAS bf16x8*)(VT + (16 * (4 * hf + t4) + r) * TS + (32 * kk + 8 * q) * 2);
                __builtin_amdgcn_sched_barrier(0);
#pragma unroll
                for (int t4 = 0; t4 < 4; ++t4) {
                    const int ni = 4 * hf + t4;
                    f32x4 acc = accS[ni] * dkc;
#pragma unroll
                    for (int kk = 0; kk < 2; ++kk) acc = __builtin_amdgcn_mfma_f32_16x16x32_bf16(ka[kk], vb[2 * t4 + kk], acc, 0, 0, 0);
                    accS[ni] = acc;
                }
                __builtin_amdgcn_sched_barrier(0);
            }
#pragma unroll
            for (int ni = 0; ni < 8; ++ni) { u32x2 sw; sw.x = pg8::cvt_pk_bf16(accS[ni][0], accS[ni][1]); sw.y = pg8::cvt_pk_bf16(accS[ni][2], accS[ni][3]);
                *(LAS u32x2*)(ST + (16 * ni + r) * QS + (16 * w + 4 * q) * 2) = sw; }
        }
    }
    {   f32x4* tg4 = (f32x4*)TG + ((size_t)item * 8 + w) * 8 * 64 + lane;
#pragma unroll
        for (int ni = 0; ni < 8; ++ni) tg4[ni * 64] = accS[ni];
        if (tg == 0) *(f32x2*)(DSEG + (size_t)item * 128 + 2 * kp) = (f32x2){cum0, cum1};
    }
    __syncthreads();
}

__device__ __forceinline__ void hgrn_p2(LAS unsigned char* lds, const bf16_t* PROJ, const bf16_t* OLOC, const float* TG, const float* CUMG, const float* DSEG, const float* nw, bf16_t* MIX, int item, int tid_in) {
    int tid = tid_in; asm volatile("" : "+v"(tid));
    constexpr int QS = 272;
    LAS unsigned char* Qd = lds;
    LAS unsigned char* ST = lds + 17408;
    LAS unsigned char* NRM = ST + 34816;
    LAS unsigned char* OT = NRM + 2048;
    const int lane = tid & 63, w = __builtin_amdgcn_readfirstlane(tid >> 6), r = lane & 15, q = lane >> 4;
    const int b = item >> 5, h = (item >> 2) & 7, g = item & 3;
    const size_t row0 = (size_t)b * SEQ + (size_t)g * 512;
    const int ci = w & 3, vh = w >> 2;
    f32x4 sin[8];
#pragma unroll
    for (int i = 0; i < 8; ++i) sin[i] = (f32x4){0.f, 0.f, 0.f, 0.f};
    for (int gp = 0; gp < g; ++gp) {
        const int it2 = item - g + gp;
        const f32x4 ds = *(const f32x4*)(DSEG + (size_t)it2 * 128 + 16 * w + 4 * q);
        const f32x4* tg4 = (const f32x4*)TG + ((size_t)it2 * 8 + w) * 8 * 64 + lane;
#pragma unroll
        for (int ni = 0; ni < 8; ++ni) sin[ni] = sin[ni] * ds + tg4[ni * 64];
    }
    const float* cumg = CUMG + ((size_t)(b * 8 + h) * 32 + g * 8) * 128 + 16 * w + 4 * q;
    const char* qbase = (const char*)(PROJ + row0 * INC + h * HD);
    const unsigned qoff = (unsigned)(tid >> 4) * (INC * 2) + (unsigned)(tid & 15) * 16u;
    const char* gbase = (const char*)(PROJ + (row0 + 16 * ci) * INC + 3 * HW + h * HD + 64 * vh);
    const unsigned go = (unsigned)r * (INC * 2) + 8u * (unsigned)q;
    const float* nwp = nw + h * HD + 64 * vh + 4 * q;
    f32x4 nv[4];
#pragma unroll
    for (int i = 0; i < 4; ++i) nv[i] = *(const f32x4*)(nwp + 16 * i);
    u32x4 lq[2]; u32x2 lo[4], gt[4]; f32x4 cmn;
#define HP2_LOAD(nn) do { \
        if (g > 0) { _Pragma("unroll") for (int j = 0; j < 2; ++j) lq[j] = *(const u32x4*)(qbase + (size_t)((nn) * 64 + 32 * j) * INC * 2 + qoff); cmn = *(const f32x4*)(cumg + (nn) * 128); } \
        const bf16_t* op_ = OLOC + (row0 + (size_t)(nn) * 64 + 16 * ci + r) * HW + h * HD + 64 * vh + 4 * q; \
        _Pragma("unroll") for (int i = 0; i < 4; ++i) { lo[i] = *(const u32x2*)(op_ + 16 * i); gt[i] = *(const u32x2*)(gbase + (size_t)(nn) * 64 * INC * 2 + (size_t)(32 * i) + go); } \
    } while (0)
    HP2_LOAD(0);
    __syncthreads();
    for (int n = 0; n < 8; ++n) {
        f32x4 o[4]; u32x2 gc[4];
#pragma unroll
        for (int i = 0; i < 4; ++i) { o[i] = (f32x4){bf_lo(lo[i].x), bf_hi(lo[i].x), bf_lo(lo[i].y), bf_hi(lo[i].y)}; gc[i] = gt[i]; }
        if (g > 0) {
            const f32x4 cm = cmn;
#pragma unroll
            for (int ni = 0; ni < 8; ++ni) { const f32x4 sv = sin[ni] * cm; u32x2 sw; sw.x = pg8::cvt_pk_bf16(sv[0], sv[1]); sw.y = pg8::cvt_pk_bf16(sv[2], sv[3]);
                *(LAS u32x2*)(ST + (16 * ni + r) * QS + (16 * w + 4 * q) * 2) = sw; }
#pragma unroll
            for (int j = 0; j < 2; ++j) { const int t = (tid >> 4) + 32 * j, c = tid & 15; *(LAS u32x4*)(Qd + t * QS + c * 16) = lq[j]; }
        }
        __syncthreads();
        if (n + 1 < 8) HP2_LOAD(n + 1);
        if (g > 0) {
            bf16x8 qa[4], bb[4];
#pragma unroll
            for (int kk = 0; kk < 4; ++kk) qa[kk] = *(const LAS bf16x8*)(Qd + (16 * ci + r) * QS + (32 * kk + 8 * q) * 2);
#pragma unroll
            for (int i = 0; i < 4; ++i) {
#pragma unroll
                for (int kk = 0; kk < 4; ++kk) bb[kk] = *(const LAS bf16x8*)(ST + (16 * (4 * vh + i) + r) * QS + (32 * kk + 8 * q) * 2);
                __builtin_amdgcn_sched_barrier(0);
                f32x4 acc = o[i];
#pragma unroll
                for (int kk = 0; kk < 4; ++kk) acc = __builtin_amdgcn_mfma_f32_16x16x32_bf16(bb[kk], qa[kk], acc, 0, 0, 0);
                o[i] = acc;
                __builtin_amdgcn_sched_barrier(0);
            }
        }
        {
            float sq = 0.f;
#pragma unroll
            for (int i = 0; i < 4; ++i) sq += (o[i][0] * o[i][0] + o[i][1] * o[i][1]) + (o[i][2] * o[i][2] + o[i][3] * o[i][3]);
            *(LAS float*)(NRM + ((vh * 4 + q) * 64 + 16 * ci + r) * 4) = sq;
        }
        __syncthreads();
        {
            float ssum = 0.f;
#pragma unroll
            for (int gg = 0; gg < 8; ++gg) ssum += *(const LAS float*)(NRM + (gg * 64 + 16 * ci + r) * 4);
            const float rs = __builtin_amdgcn_rsqf(ssum * (1.0f / HD) + EPS);
            LAS unsigned char* ot = OT + w * 2304;
#pragma unroll
            for (int i = 0; i < 4; ++i) {
                const float g0 = bf_lo(gc[i].x), g1 = bf_hi(gc[i].x), g2 = bf_lo(gc[i].y), g3 = bf_hi(gc[i].y);
                u32x2 ow; ow.x = pg8::cvt_pk_bf16(o[i][0] * rs * nv[i][0] * siluf_(g0), o[i][1] * rs * nv[i][1] * siluf_(g1));
                ow.y = pg8::cvt_pk_bf16(o[i][2] * rs * nv[i][2] * siluf_(g2), o[i][3] * rs * nv[i][3] * siluf_(g3));
                *(LAS u32x2*)(ot + r * 144 + (16 * i + 4 * q) * 2) = ow;
            }
            asm volatile("s_waitcnt lgkmcnt(0)" ::: "memory");
#pragma unroll
            for (int j = 0; j < 2; ++j) { const int rr = (lane >> 3) + 8 * j, pc = lane & 7;
                const u32x4 ov = *(const LAS u32x4*)(ot + rr * 144 + pc * 16);
                *(u32x4*)(MIX + (row0 + (size_t)n * 64 + 16 * ci + rr) * D + h * HD + 64 * vh + pc * 8) = ov; }
        }
        __syncthreads();
    }
#undef HP2_LOAD
}

struct Args { const float* in[16]; float* out; unsigned char* ws; int use_cg; int pad; };

__global__ void __launch_bounds__(512, 2) mk_fwd(Args a) {
    extern __shared__ __attribute__((aligned(16))) unsigned char lds_raw[];
    LAS unsigned char* lds = (LAS unsigned char*)lds_raw;
    cg::grid_group grid = cg::this_grid();
    const int tid = threadIdx.x, lane = tid & 63, wave = __builtin_amdgcn_readfirstlane(tid >> 6);
    const int G = gridDim.x, bid = blockIdx.x;
    unsigned char* ws = a.ws;
    float* ssq0 = (float*)(ws + WS_SSQ); float* ssq1 = ssq0 + M; float* ssq2 = ssq1 + M; float* ssq3 = ssq2 + M;
    float* ssqh = (float*)(ws + WS_SSQH);
    bf16_t* W1GU = (bf16_t*)(ws + WS_W1GU); bf16_t* W1D = (bf16_t*)(ws + WS_W1D); bf16_t* WIN = (bf16_t*)(ws + WS_WIN); bf16_t* WOUT = (bf16_t*)(ws + WS_WOUT);
    bf16_t* W2GU = (bf16_t*)(ws + WS_W2GU); bf16_t* W2D = (bf16_t*)(ws + WS_W2D);
    bf16_t* MIX = (bf16_t*)(ws + WS_MIX); bf16_t* XB = (bf16_t*)(ws + WS_XB); float* OUN = (float*)(ws + WS_XB);
    bf16_t* HB = (bf16_t*)(ws + WS_BIG); bf16_t* PROJ = (bf16_t*)(ws + WS_BIG);
    bf16_t* OLOC = (bf16_t*)a.out;
    float* OLOC_unused = (float*)(ws + WS_XB); (void)OLOC_unused; float* TGS = (float*)(ws + WS_TG); float* CUMG = (float*)(ws + WS_CUM); float* DSEG = (float*)(ws + WS_DSEG);
    const float* x = a.in[0]; float* out = a.out;
    if (tid < 64) ((LAS unsigned*)(lds + LDS_CTL))[tid] = 0u;
    __syncthreads();
    const XcdBarrier xbar = xcd_barrier_post((unsigned*)(ws + WS_BAR), (volatile LAS unsigned*)(lds + LDS_CTL + 32));
#define GRID_BAR() do { if (a.use_cg) grid.sync(); else xcd_barrier(xbar); } while (0)

    {
        LAS float* scr = (LAS float*)(lds + wave * 16384);
        const int gw = bid * 8 + wave, NGW = G * 8;
        constexpr int I_GU = (D / 64) * (FF / 32), I_DN = (FF / 64) * (D / 32), I_IN = (D / 64) * (INC / 32), I_OUT = (D / 64) * (D / 32);
        constexpr int NITEMS = 4 * I_GU + 2 * I_DN + I_IN + I_OUT;
        auto desc = [&](int it) -> P0Desc {
            int r = it;
            if (r < I_GU) return P0Desc{a.in[2], W1GU, a.in[1], D, FF, 1, r}; r -= I_GU;
            if (r < I_GU) return P0Desc{a.in[3], W1GU, a.in[1], D, FF, 2, r}; r -= I_GU;
            if (r < I_DN) return P0Desc{a.in[4], W1D, nullptr, FF, D, 0, r}; r -= I_DN;
            if (r < I_IN) return P0Desc{a.in[6], WIN, a.in[5], D, INC, 3, r}; r -= I_IN;
            if (r < I_OUT) return P0Desc{a.in[10], WOUT, nullptr, D, D, 0, r}; r -= I_OUT;
            if (r < I_GU) return P0Desc{a.in[12], W2GU, a.in[11], D, FF, 1, r}; r -= I_GU;
            if (r < I_GU) return P0Desc{a.in[13], W2GU, a.in[11], D, FF, 2, r}; r -= I_GU;
            return P0Desc{a.in[14], W2D, nullptr, FF, D, 0, r};
        };
        {
            f32x4 va[8], vb[8]; float sa[8], sb[8];
            int it = gw;
            P0Desc da = desc(it < NITEMS ? it : 0), db = da;
            if (it < NITEMS) p0_load(da, va, sa, lane);
            while (it < NITEMS) {
                const int itb = it + NGW;
                if (itb < NITEMS) { db = desc(itb); p0_load(db, vb, sb, lane); }
                p0_finish(da, va, sa, scr, lane);
                if (itb >= NITEMS) break;
                const int ita = itb + NGW;
                if (ita < NITEMS) { da = desc(ita); p0_load(da, va, sa, lane); }
                p0_finish(db, vb, sb, scr, lane);
                it = ita;
            }
        }
        for (int m = gw; m < M; m += NGW) {
            const f32x4* xr = (const f32x4*)(x + (size_t)m * D) + lane; u32x2* o8 = (u32x2*)(XB + (size_t)m * D) + lane; float s = 0.f;
#pragma unroll
            for (int j = 0; j < 8; ++j) { const f32x4 v = xr[64 * j]; s += (v[0] * v[0] + v[1] * v[1]) + (v[2] * v[2] + v[3] * v[3]); u32x2 w; w.x = pk2(v[0], v[1]); w.y = pk2(v[2], v[3]); o8[64 * j] = w; }
            s = wave_sum(s);
            if (lane == 0) ssq0[m] = s;
        }
        for (int i = bid * 512 + tid; i < 3 * M; i += G * 512) ssq1[i] = 0.f;
    }
    GRID_BAR();

    { pg8::Gemm g{XB, W1GU, M, 2 * FF, D}; pg8::StaticOrder S; S.init(M, 2 * FF, G, bid); pg8::EpiSwiGLU E{HB, ssq0}; pg8::gemm_phase<pg8::EpiSwiGLU>(lds, g, S, E); }
    GRID_BAR();
    { pg8::Gemm g{HB, W1D, M, D, FF}; pg8::StaticOrder S; S.init(M, D, G, bid); pg8::EpiResid<true, true> E{nullptr, XB, nullptr, XB, ssq1, 0.5f}; pg8::gemm_phase<pg8::EpiResid<true, true>>(lds, g, S, E); }
    GRID_BAR();
    { pg8::Gemm g{XB, WIN, M, INC, D}; pg8::StaticOrder S; S.init(M, INC, G, bid); pg8::EpiProj E{PROJ, ssq1}; pg8::gemm_phase<pg8::EpiProj>(lds, g, S, E); }
    GRID_BAR();

    for (int item = bid; item < 256; item += G) hgrn_p1(lds, PROJ, a.in[7], OLOC, TGS, CUMG, DSEG, item, tid);
    {
        const float* cw = a.in[9];
        const size_t stride = (size_t)G * 512, total = (size_t)M * 128;
        const int c0 = (tid & 127) * 8;
        f32x4 wa[3], wb[3];
#pragma unroll
        for (int d = 0; d < 3; ++d) { wa[d] = *(const f32x4*)(cw + d * HW + c0); wb[d] = *(const f32x4*)(cw + d * HW + c0 + 4); }
        for (size_t idx0 = (size_t)bid * 512 + tid; idx0 < total; idx0 += 2 * stride) {
            u32x4 bb[2], cc[2][3]; float ok[2][3]; size_t rows[2]; bool have[2];
#pragma unroll
            for (int u = 0; u < 2; ++u) {
                const size_t idx = idx0 + u * stride; have[u] = idx < total;
                const size_t row = have[u] ? (idx >> 7) : (idx0 >> 7); rows[u] = row; const int t = (int)(row & (SEQ - 1));
                const bf16_t* pr = PROJ + row * INC;
                bb[u] = *(const u32x4*)(pr + 4 * HW + c0);
#pragma unroll
                for (int d = 0; d < 3; ++d) { const bool v = (t - 2 + d) >= 0; ok[u][d] = v ? 1.f : 0.f; const bf16_t* p2 = v ? pr - (size_t)(2 - d) * INC : pr;
                    cc[u][d] = *(const u32x4*)(p2 + 5 * HW + c0); }
            }
#pragma unroll
            for (int u = 0; u < 2; ++u) {
                float acc8[8];
#pragma unroll
                for (int j = 0; j < 8; ++j) acc8[j] = 0.f;
#pragma unroll
                for (int d = 0; d < 3; ++d) {
                    const u32x4 c4 = cc[u][d]; const float m = ok[u][d];
                    const float cv[8] = {bf_lo(c4.x), bf_hi(c4.x), bf_lo(c4.y), bf_hi(c4.y), bf_lo(c4.z), bf_hi(c4.z), bf_lo(c4.w), bf_hi(c4.w)};
#pragma unroll
                    for (int j = 0; j < 4; ++j) { acc8[j] += (wa[d][j] * m) * cv[j]; acc8[4 + j] += (wb[d][j] * m) * cv[4 + j]; }
                }
                const u32x4 b4 = bb[u];
                const float bv[8] = {bf_lo(b4.x), bf_hi(b4.x), bf_lo(b4.y), bf_hi(b4.y), bf_lo(b4.z), bf_hi(b4.z), bf_lo(b4.w), bf_hi(b4.w)};
                u32x4 w; w.x = pk2(bv[0] * acc8[0], bv[1] * acc8[1]); w.y = pk2(bv[2] * acc8[2], bv[3] * acc8[3]); w.z = pk2(bv[4] * acc8[4], bv[5] * acc8[5]); w.w = pk2(bv[6] * acc8[6], bv[7] * acc8[7]);
                if (have[u]) *(u32x4*)(MIX + rows[u] * D + HW + c0) = w;
            }
        }
    }
    GRID_BAR();
    for (int item = bid; item < 256; item += G) hgrn_p2(lds, PROJ, OLOC, TGS, CUMG, DSEG, a.in[8], MIX, item, tid);
    GRID_BAR();


    { pg8::Gemm g{MIX, WOUT, M, D, D}; pg8::StaticOrder S; S.init(M, D, G, bid); pg8::EpiResid<true, true> E{nullptr, XB, nullptr, XB, ssq2, 1.0f}; pg8::gemm_phase<pg8::EpiResid<true, true>>(lds, g, S, E); }
    GRID_BAR();
    { pg8::Gemm g{XB, W2GU, M, 2 * FF, D}; pg8::StaticOrder S; S.init(M, 2 * FF, G, bid); pg8::EpiSwiGLU E{HB, ssq2}; pg8::gemm_phase<pg8::EpiSwiGLU>(lds, g, S, E); }
    GRID_BAR();
    { pg8::Gemm g{HB, W2D, M, D, FF}; pg8::StaticOrder S; S.init(M, D, G, bid); pg8::EpiResid<true, true> E{nullptr, XB, nullptr, XB, ssq3, 0.5f}; pg8::gemm_phase<pg8::EpiResid<true, true>>(lds, g, S, E); }
    GRID_BAR();
    {
        const float* fw = a.in[15];
        for (size_t idx = (size_t)bid * 512 + tid; idx < (size_t)M * (D / 8); idx += (size_t)G * 512) {
            const size_t row = idx >> 8; const int c8 = (int)(idx & 255) * 8;
            const float rs = __builtin_amdgcn_rsqf(ssq3[row] * (1.0f / D) + EPS);
            const u32x4 xv = *(const u32x4*)(XB + row * D + c8); const f32x4 w0 = *(const f32x4*)(fw + c8), w1 = *(const f32x4*)(fw + c8 + 4);
            const f32x4 v0 = (f32x4){bf_lo(xv.x), bf_hi(xv.x), bf_lo(xv.y), bf_hi(xv.y)}, v1 = (f32x4){bf_lo(xv.z), bf_hi(xv.z), bf_lo(xv.w), bf_hi(xv.w)};
            *(f32x4*)(out + row * D + c8) = v0 * rs * w0; *(f32x4*)(out + row * D + c8 + 4) = v1 * rs * w1;
        }
    }
}

extern "C" void kernel_launch(void* const* d_in, const int* in_sizes, int n_in, void* d_out, int out_size,
                              void* d_ws, size_t ws_size, hipStream_t stream) {
    static int grid = 0;
    if (grid == 0) {
        if (n_in != 16 || in_sizes[0] != M * D || out_size != M * D || ws_size < WS_END) { fprintf(stderr, "kernel_launch: unexpected shapes / workspace (%d inputs, ws %zu)\n", n_in, ws_size); grid = -1; return; }
        int dev = 0, cus = 0, per_cu = 0;
        (void)hipGetDevice(&dev);
        (void)hipDeviceGetAttribute(&cus, hipDeviceAttributeMultiprocessorCount, dev);
        (void)hipFuncSetAttribute((const void*)mk_fwd, hipFuncAttributeMaxDynamicSharedMemorySize, LDS_BYTES);
        (void)hipOccupancyMaxActiveBlocksPerMultiprocessor(&per_cu, (const void*)mk_fwd, 512, LDS_BYTES);
        if (per_cu < 1) { fprintf(stderr, "kernel_launch: occupancy query says %d\n", per_cu); per_cu = 1; }
        grid = cus * per_cu;
    }
    if (grid < 0) return;
    Args a{};
    for (int i = 0; i < 16; ++i) a.in[i] = (const float*)d_in[i];
    a.out = (float*)d_out; a.ws = (unsigned char*)d_ws; a.use_cg = 0; a.pad = 0;
    if (hipMemsetAsync((char*)d_ws + WS_BAR, 0, BAR_BYTES, stream) != hipSuccess) { fprintf(stderr, "kernel_launch: memset failed\n"); return; }
    void* args[] = {&a};
    hipError_t e = hipLaunchCooperativeKernel((const void*)mk_fwd, dim3(grid), dim3(512), args, LDS_BYTES, stream);
    if (e != hipSuccess) fprintf(stderr, "cooperative launch failed: %s (grid %d)\n", hipGetErrorString(e), grid);
}
```

```cpp
#include <hip/hip_runtime.h>
#include <hip/hip_cooperative_groups.h>
#include <cstdio>
#include <cstdint>
namespace cg = cooperative_groups;

#define LAS __attribute__((address_space(3)))
typedef unsigned short bf16_t;
typedef short bf16x8 __attribute__((ext_vector_type(8)));
typedef float f32x4 __attribute__((ext_vector_type(4)));
typedef float f32x2 __attribute__((ext_vector_type(2)));
typedef unsigned u32x4 __attribute__((ext_vector_type(4)));
typedef unsigned u32x2 __attribute__((ext_vector_type(2)));

constexpr int D = 2048, M = 16384, SEQ = 2048, FF = 5632, HW = 1024, NHEAD = 8, HD = 128, INC = 7168;
constexpr float EPS = 1e-6f;
constexpr size_t MiB = 1u << 20;
constexpr size_t WS_SSQ = 0;
constexpr size_t WS_BAR = 1 * MiB, BAR_BYTES = 16384;
constexpr size_t WS_SSQH = 2 * MiB;
constexpr size_t WS_W1GU = 4 * MiB, WS_W1D = 48 * MiB, WS_WIN = 70 * MiB, WS_WOUT = 98 * MiB, WS_W2GU = 106 * MiB, WS_W2D = 150 * MiB;
constexpr size_t WS_MIX = 4 * MiB;
constexpr size_t WS_XB = 172 * MiB;
constexpr size_t WS_BIG = 236 * MiB;
constexpr size_t WS_TG = 460 * MiB;
constexpr size_t WS_CUM = 476 * MiB;
constexpr size_t WS_DSEG = 477 * MiB;
constexpr size_t WS_END = 478 * MiB;
constexpr int LDS_BYTES = 147456, LDS_CTL = 131072;

__device__ __forceinline__ unsigned f2bf(float f) { unsigned u = __builtin_bit_cast(unsigned, f); return (u + 0x7fffu + ((u >> 16) & 1u)) >> 16; }
__device__ __forceinline__ unsigned pk2(float lo, float hi) { return f2bf(lo) | (f2bf(hi) << 16); }
__device__ __forceinline__ float bf_lo(unsigned w) { return __builtin_bit_cast(float, w << 16); }
__device__ __forceinline__ float bf_hi(unsigned w) { return __builtin_bit_cast(float, w & 0xffff0000u); }
__device__ __forceinline__ float sigmoidf_(float x) { return __builtin_amdgcn_rcpf(1.0f + __builtin_amdgcn_exp2f(-1.4426950408889634f * x)); }
__device__ __forceinline__ float siluf_(float x) { return x * sigmoidf_(x); }

namespace pg8 {
constexpr int BM = 256, BK = 64, HALF = 128, HTB = HALF * BK * 2, STAGE_BYTES = 8 * HTB, NXCD = 8, WGM = 4;
__host__ __device__ __forceinline__ int lds_byte(int r, int c) { const int st = (r >> 4) * 2 + (c >> 5), rr = r & 15, cc = c & 31, ob = rr * 64 + cc * 2; return st * 1024 + (ob ^ (((ob >> 9) & 1) << 5)); }
__host__ __device__ __forceinline__ void stage_rc(int b, int& R, int& C) { const int st = b / 1024, sb = b % 1024, swz = sb ^ (((sb >> 9) & 1) << 5); R = (st >> 1) * 16 + swz / 64; C = (st & 1) * 32 + (swz % 64) / 2; }
__host__ __device__ __forceinline__ int perm32(int rho) { const int n = rho >> 4, i = rho & 15; return 8 * (i >> 2) + 4 * n + (i & 3); }

struct Unit { int pm, pn; };
struct Gemm { const bf16_t* A; const bf16_t* Bt; int M, N, K; };

struct StaticOrder {
    int nM, nN, nwg, G, c;
    __host__ __device__ void init(int M_, int N_, int G_, int c_) { nM = M_ / BM; nN = N_ / BM; nwg = nM * nN; G = G_; c = c_; }
    __host__ __device__ bool next(int i, Unit& u) const {
        const long L = (long)i * G + c; if (L >= nwg) return false;
        int wgid = (int)L; { const int q = nwg / NXCD, r = nwg % NXCD, xcd = wgid % NXCD, off = wgid / NXCD; wgid = (xcd < r ? xcd * (q + 1) : r * (q + 1) + (xcd - r) * q) + off; }
        const int nig = WGM * nN, gid = wgid / nig, fm = gid * WGM, gsz = (nM - fm) < WGM ? (nM - fm) : WGM;
        u.pm = fm + ((wgid % nig) % gsz); u.pn = (wgid % nig) / gsz; return true;
    }
};

typedef __bf16 bf16x2_t __attribute__((ext_vector_type(2)));
__device__ __forceinline__ unsigned cvt_pk_bf16(float lo, float hi) { const f32x2 v = {lo, hi}; const bf16x2_t b = __builtin_convertvector(v, bf16x2_t); return __builtin_bit_cast(unsigned, b); }

struct EpiSwiGLU {
    static constexpr bool PERM = true;
    bf16_t* O; const float* ssq;
    __device__ __forceinline__ void operator()(const f32x4 (&acc)[2][2][4][2], const Unit& u, int wr, int wc, int fr, int fq) const {
        const int row0 = u.pm * BM + wr * 64 + fr, col0 = u.pn * HALF + wc * 32 + 8 * fq;
        float rsv[2][4];
#pragma unroll
        for (int ai = 0; ai < 2; ++ai)
#pragma unroll
            for (int m = 0; m < 4; ++m) rsv[ai][m] = ssq[row0 + ai * HALF + m * 16];
        __builtin_amdgcn_sched_barrier(0);
#pragma unroll
        for (int ai = 0; ai < 2; ++ai)
#pragma unroll
            for (int m = 0; m < 4; ++m) {
                const int row = row0 + ai * HALF + m * 16;
                const float rs = __builtin_amdgcn_rsqf(rsv[ai][m] * (1.0f / D) + EPS);
                f32x4 h0, h1;
#pragma unroll
                for (int j = 0; j < 4; ++j) { h0[j] = siluf_(acc[ai][0][m][0][j] * rs) * (acc[ai][1][m][0][j] * rs); h1[j] = siluf_(acc[ai][0][m][1][j] * rs) * (acc[ai][1][m][1][j] * rs); }
                u32x4 w; w.x = cvt_pk_bf16(h0[0], h0[1]); w.y = cvt_pk_bf16(h0[2], h0[3]); w.z = cvt_pk_bf16(h1[0], h1[1]); w.w = cvt_pk_bf16(h1[2], h1[3]);
                __builtin_nontemporal_store(w, (u32x4*)(O + (size_t)row * FF + col0));
            }
    }
};
struct EpiProj {
    static constexpr bool PERM = true;
    bf16_t* O; const float* ssq;
    __device__ __forceinline__ void operator()(const f32x4 (&acc)[2][2][4][2], const Unit& u, int wr, int wc, int fr, int fq) const {
        const int row0 = u.pm * BM + wr * 64 + fr, col0 = u.pn * BM + wc * 32 + 8 * fq;
        float rsv[2][4];
#pragma unroll
        for (int ai = 0; ai < 2; ++ai)
#pragma unroll
            for (int m = 0; m < 4; ++m) rsv[ai][m] = ssq[row0 + ai * HALF + m * 16];
        __builtin_amdgcn_sched_barrier(0);
#pragma unroll
        for (int ai = 0; ai < 2; ++ai)
#pragma unroll
            for (int m = 0; m < 4; ++m) {
                const int row = row0 + ai * HALF + m * 16;
                const float rs = __builtin_amdgcn_rsqf(rsv[ai][m] * (1.0f / D) + EPS);
                if (u.pn >= 20) {
                    const float rs2 = rs * rs;
                    const f32x4 v0 = acc[ai][0][m][0] * acc[ai][1][m][0] * rs2, v1 = acc[ai][0][m][1] * acc[ai][1][m][1] * rs2;
                    u32x4 w; w.x = cvt_pk_bf16(v0[0], v0[1]); w.y = cvt_pk_bf16(v0[2], v0[3]); w.z = cvt_pk_bf16(v1[0], v1[1]); w.w = cvt_pk_bf16(v1[2], v1[3]);
                    *(u32x4*)(O + (size_t)row * INC + 5 * HW + (u.pn - 20) * HALF + wc * 32 + 8 * fq) = w;
                } else {
#pragma unroll
                for (int bj = 0; bj < 2; ++bj) { const f32x4 v0 = acc[ai][bj][m][0] * rs, v1 = acc[ai][bj][m][1] * rs;
                    u32x4 w; w.x = cvt_pk_bf16(v0[0], v0[1]); w.y = cvt_pk_bf16(v0[2], v0[3]); w.z = cvt_pk_bf16(v1[0], v1[1]); w.w = cvt_pk_bf16(v1[2], v1[3]);
                    *(u32x4*)(O + (size_t)row * INC + col0 + bj * HALF) = w; }
                }
            }
    }
};
template <bool BASE_BF, bool OUT_BF> struct EpiResid {
    static constexpr bool PERM = true;
    const float* basef; const bf16_t* baseb; float* outf; bf16_t* outb; float* ssq; float scale;
    __device__ __forceinline__ void operator()(const f32x4 (&acc)[2][2][4][2], const Unit& u, int wr, int wc, int fr, int fq) const {
        const int row0 = u.pm * BM + wr * 64 + fr, col0 = u.pn * BM + wc * 32 + 8 * fq;
#pragma unroll
        for (int ai = 0; ai < 2; ++ai) {
            f32x4 b[4][2][2];
#pragma unroll
            for (int m = 0; m < 4; ++m) { const size_t off = (size_t)(row0 + ai * HALF + m * 16) * D + col0;
#pragma unroll
                for (int bj = 0; bj < 2; ++bj) {
                    if (BASE_BF) { const u32x4 w = *(const u32x4*)(baseb + off + bj * HALF);
                        b[m][bj][0] = (f32x4){bf_lo(w.x), bf_hi(w.x), bf_lo(w.y), bf_hi(w.y)}; b[m][bj][1] = (f32x4){bf_lo(w.z), bf_hi(w.z), bf_lo(w.w), bf_hi(w.w)}; }
                    else { b[m][bj][0] = *(const f32x4*)(basef + off + bj * HALF); b[m][bj][1] = *(const f32x4*)(basef + off + bj * HALF + 4); } } }
            __builtin_amdgcn_sched_barrier(0);
#pragma unroll
            for (int m = 0; m < 4; ++m) {
                const int row = row0 + ai * HALF + m * 16; const size_t off = (size_t)row * D + col0; float s = 0.f;
#pragma unroll
                for (int bj = 0; bj < 2; ++bj) {
                    const f32x4 v0 = b[m][bj][0] + acc[ai][bj][m][0] * scale, v1 = b[m][bj][1] + acc[ai][bj][m][1] * scale;
                    s += ((v0[0] * v0[0] + v0[1] * v0[1]) + (v0[2] * v0[2] + v0[3] * v0[3])) + ((v1[0] * v1[0] + v1[1] * v1[1]) + (v1[2] * v1[2] + v1[3] * v1[3]));
                    if (OUT_BF) { u32x4 w; w.x = cvt_pk_bf16(v0[0], v0[1]); w.y = cvt_pk_bf16(v0[2], v0[3]); w.z = cvt_pk_bf16(v1[0], v1[1]); w.w = cvt_pk_bf16(v1[2], v1[3]); *(u32x4*)(outb + off + bj * HALF) = w; }
                    else { *(f32x4*)(outf + off + bj * HALF) = v0; *(f32x4*)(outf + off + bj * HALF + 4) = v1; }
                }
                s += __shfl_xor(s, 16); s += __shfl_xor(s, 32);
                if (fq == 0) (void)__hip_atomic_fetch_add(ssq + row, s, __ATOMIC_RELAXED, __HIP_MEMORY_SCOPE_AGENT);
            }
            asm volatile("" ::: "memory");
        }
    }
};

template <class Epi, bool ALIGN_EPI = true, bool SP2 = true>
__device__ __forceinline__ void gemm_phase(LAS unsigned char* lds, const Gemm g, const StaticOrder& S, const Epi& E) {
    int tid = threadIdx.x; asm volatile("" : "+v"(tid));
    const int wid = __builtin_amdgcn_readfirstlane(tid >> 6), lane = tid & 63, wr = wid >> 2, wc = wid & 3, fr = lane & 15, fq = lane >> 4;
    const int K = g.K, nt = K / BK;
    unsigned voffA[2], voffB[2];
#pragma unroll
    for (int i = 0; i < 2; ++i) { int R, C; stage_rc(tid * 16 + i * 8192, R, C); const int Rb = Epi::PERM ? ((R & ~31) + perm32(R & 31)) : R;
        voffA[i] = (unsigned)(R * K + C) * 2u; voffB[i] = (unsigned)(Rb * K + C) * 2u; }
    const size_t kstep = (size_t)(BK * 2);
    const size_t hstep = (size_t)HALF * K * 2;
    const size_t tstep = 2 * hstep;
    const unsigned ldsw = (unsigned)wid * 1024u;
    const int aoff = lds_byte(wr * 64 + fr, fq * 8), boff = lds_byte(wc * 32 + fr, fq * 8);
#define PG8_SA(b, h) (((b) * 2 + (h)) * HTB)
#define PG8_SB(b, h) ((4 + (b) * 2 + (h)) * HTB)
#define PG8_STAGE(bufoff, gbase, voff) do { _Pragma("unroll") for (int _i = 0; _i < 2; ++_i) \
        __builtin_amdgcn_global_load_lds((const unsigned*)((const char*)(gbase) + (voff)[_i]), (LAS unsigned*)(lds + (bufoff) + ldsw + _i * 8192), 16, 0, 0); } while (0)
#define PG8_LDA(dst, b, h) do { _Pragma("unroll") for (int m = 0; m < 4; ++m) _Pragma("unroll") for (int k = 0; k < 2; ++k) dst[m][k] = *(const LAS bf16x8*)(lds + PG8_SA(b, h) + aoff + m * 2048 + k * 1024); } while (0)
#define PG8_LDB(dst, b, h) do { _Pragma("unroll") for (int n = 0; n < 2; ++n) _Pragma("unroll") for (int k = 0; k < 2; ++k) dst[n][k] = *(const LAS bf16x8*)(lds + PG8_SB(b, h) + boff + n * 2048 + k * 1024); } while (0)
#define PG8_MMA(ai, bj, At, Bt) do { __builtin_amdgcn_s_setprio(1); _Pragma("unroll") for (int m = 0; m < 4; ++m) _Pragma("unroll") for (int n = 0; n < 2; ++n) _Pragma("unroll") for (int k = 0; k < 2; ++k) \
        acc[ai][bj][m][n] = __builtin_amdgcn_mfma_f32_16x16x32_bf16(Bt[n][k], At[m][k], acc[ai][bj][m][n], 0, 0, 0); __builtin_amdgcn_s_setprio(0); } while (0)
#define PG8_WAIT_V(n) asm volatile("s_waitcnt vmcnt(" #n ")" ::: "memory")
#define PG8_WAIT_L(n) asm volatile("s_waitcnt lgkmcnt(" #n ")" ::: "memory")
#define PG8_BAR __builtin_amdgcn_s_barrier()
#define PG8_SCHED __builtin_amdgcn_sched_barrier(0)
    Unit cur, nxt; int ui = 0;
    if (!S.next(0, cur)) return;
    f32x4 acc[2][2][4][2];
#pragma unroll
    for (int a = 0; a < 2; ++a)
#pragma unroll
        for (int b = 0; b < 2; ++b)
#pragma unroll
            for (int m = 0; m < 4; ++m)
#pragma unroll
                for (int n = 0; n < 2; ++n) acc[a][b][m][n] = (f32x4){0.f, 0.f, 0.f, 0.f};
    bf16x8 At[4][2], B0[2][2], B1[2][2];
    const char* cA = (const char*)g.A + (size_t)cur.pm * tstep; const char* cB = (const char*)g.Bt + (size_t)cur.pn * tstep;
    if constexpr (SP2) {
        PG8_STAGE(PG8_SB(0, 0), cB, voffB); PG8_STAGE(PG8_SB(0, 1), cB + hstep, voffB); PG8_STAGE(PG8_SA(0, 0), cA, voffA); PG8_STAGE(PG8_SA(0, 1), cA + hstep, voffA);
        if (wr == 1) PG8_BAR;
        PG8_WAIT_V(2); PG8_BAR;
        PG8_STAGE(PG8_SB(1, 0), cB + kstep, voffB); PG8_STAGE(PG8_SA(1, 0), cA + kstep, voffA); PG8_STAGE(PG8_SB(1, 1), cB + hstep + kstep, voffB);
        PG8_WAIT_V(6); PG8_BAR;
    } else {
        PG8_STAGE(PG8_SB(0, 0), cB, voffB); PG8_STAGE(PG8_SA(0, 0), cA, voffA); PG8_STAGE(PG8_SB(0, 1), cB + hstep, voffB); PG8_STAGE(PG8_SA(0, 1), cA + hstep, voffA);
        if (wr == 1) PG8_BAR;
        PG8_WAIT_V(4); PG8_BAR;
        PG8_STAGE(PG8_SB(1, 0), cB + kstep, voffB); PG8_STAGE(PG8_SA(1, 0), cA + kstep, voffA); PG8_STAGE(PG8_SB(1, 1), cB + hstep + kstep, voffB);
        PG8_WAIT_V(6); PG8_BAR;
    }
    for (;;) {
        const bool has_next = S.next(ui + 1, nxt);
        const char* nA = has_next ? (const char*)g.A + (size_t)nxt.pm * tstep : cA; const char* nB = has_next ? (const char*)g.Bt + (size_t)nxt.pn * tstep : cB;
        for (int t = 0; t < nt; t += 2) {
            const bool last = (t == nt - 2);
            const char* a1 = cA + (size_t)(t + 1) * kstep;
            const char* a2 = last ? nA : cA + (size_t)(t + 2) * kstep; const char* b2 = last ? nB : cB + (size_t)(t + 2) * kstep;
            const char* a3 = a2 + kstep; const char* b3 = b2 + kstep;
            if constexpr (SP2) {
            PG8_LDB(B0, 0, 0); PG8_LDB(B1, 0, 1); PG8_SCHED; PG8_LDA(At, 0, 0); PG8_STAGE(PG8_SA(1, 1), a1 + hstep, voffA);
            PG8_WAIT_V(8); PG8_WAIT_L(0); PG8_BAR; PG8_MMA(0, 0, At, B0); PG8_MMA(0, 1, At, B1); PG8_BAR; PG8_SCHED;
            PG8_LDA(At, 0, 1); PG8_STAGE(PG8_SB(0, 0), b2, voffB); PG8_STAGE(PG8_SB(0, 1), b2 + hstep, voffB); PG8_STAGE(PG8_SA(0, 0), a2, voffA);
            PG8_WAIT_V(8); PG8_WAIT_L(0); PG8_BAR; PG8_MMA(1, 0, At, B0); PG8_MMA(1, 1, At, B1); PG8_BAR; PG8_SCHED;
            PG8_LDB(B0, 1, 0); PG8_LDB(B1, 1, 1); PG8_SCHED; PG8_LDA(At, 1, 0); PG8_STAGE(PG8_SA(0, 1), a2 + hstep, voffA);
            PG8_WAIT_V(8); PG8_WAIT_L(0); PG8_BAR; PG8_MMA(0, 0, At, B0); PG8_MMA(0, 1, At, B1); PG8_BAR; PG8_SCHED;
            PG8_LDA(At, 1, 1); PG8_STAGE(PG8_SB(1, 0), b3, voffB); PG8_STAGE(PG8_SB(1, 1), b3 + hstep, voffB); PG8_STAGE(PG8_SA(1, 0), a3, voffA);
            PG8_WAIT_V(8); PG8_WAIT_L(0); PG8_BAR; PG8_MMA(1, 0, At, B0); PG8_MMA(1, 1, At, B1); PG8_BAR; PG8_SCHED;
            } else {
            PG8_LDB(B0, 0, 0); PG8_SCHED; PG8_LDA(At, 0, 0); PG8_STAGE(PG8_SA(1, 1), a1 + hstep, voffA);
            PG8_WAIT_L(8); PG8_BAR; PG8_WAIT_L(0); PG8_MMA(0, 0, At, B0); PG8_BAR; PG8_SCHED;
            PG8_LDB(B1, 0, 1); PG8_STAGE(PG8_SB(0, 0), b2, voffB);
            PG8_BAR; PG8_WAIT_L(0); PG8_MMA(0, 1, At, B1); PG8_BAR;
            PG8_LDA(At, 0, 1); PG8_STAGE(PG8_SA(0, 0), a2, voffA);
            PG8_BAR; PG8_WAIT_L(0); PG8_MMA(1, 0, At, B0); PG8_BAR; PG8_SCHED;
            PG8_STAGE(PG8_SB(0, 1), b2 + hstep, voffB);
            PG8_WAIT_V(6); PG8_BAR; PG8_MMA(1, 1, At, B1); PG8_BAR;
            PG8_LDB(B0, 1, 0); PG8_SCHED; PG8_LDA(At, 1, 0); PG8_STAGE(PG8_SA(0, 1), a2 + hstep, voffA);
            PG8_WAIT_L(8); PG8_BAR; PG8_WAIT_L(0); PG8_MMA(0, 0, At, B0); PG8_BAR; PG8_SCHED;
            PG8_LDB(B1, 1, 1); PG8_STAGE(PG8_SB(1, 0), b3, voffB);
            PG8_BAR; PG8_WAIT_L(0); PG8_MMA(0, 1, At, B1); PG8_BAR;
            PG8_LDA(At, 1, 1); PG8_STAGE(PG8_SA(1, 0), a3, voffA);
            PG8_BAR; PG8_WAIT_L(0); PG8_MMA(1, 0, At, B0); PG8_BAR; PG8_SCHED;
            PG8_STAGE(PG8_SB(1, 1), b3 + hstep, voffB);
            PG8_WAIT_V(6); PG8_BAR; PG8_MMA(1, 1, At, B1); PG8_BAR;
            }
        }
        if constexpr (ALIGN_EPI) { if (wr == 0) PG8_BAR; }
        E(acc, cur, wr, wc, fr, fq);
        if (!has_next) break;
#pragma unroll
        for (int a = 0; a < 2; ++a)
#pragma unroll
            for (int b = 0; b < 2; ++b)
#pragma unroll
                for (int m = 0; m < 4; ++m)
#pragma unroll
                    for (int n = 0; n < 2; ++n) acc[a][b][m][n] = (f32x4){0.f, 0.f, 0.f, 0.f};
        cur = nxt; cA = nA; cB = nB; ++ui;
        if constexpr (ALIGN_EPI) { if (wr == 1) PG8_BAR; }
    }
    PG8_WAIT_V(0);
    if constexpr (!ALIGN_EPI) { if (wr == 0) PG8_BAR; }
    PG8_BAR;
#undef PG8_SA
#undef PG8_SB
#undef PG8_STAGE
#undef PG8_LDA
#undef PG8_LDB
#undef PG8_MMA
#undef PG8_WAIT_V
#undef PG8_WAIT_L
#undef PG8_BAR
#undef PG8_SCHED
}
}

#define LDS_WAIT() asm volatile("s_waitcnt lgkmcnt(0)" ::: "memory")
__device__ __forceinline__ float wave_sum(float v) {
#pragma unroll
    for (int o = 1; o < 64; o <<= 1) v += __shfl_xor(v, o);
    return v;
}
struct P0Desc { const float* W; bf16_t* WT; const float* ks; int K, N, mode, item; };
__device__ __forceinline__ void p0_load(const P0Desc& d, f32x4 (&v)[8], float (&sc)[8], int lane) {
    const int nblk = d.N / 32, kb = d.item / nblk, nb = d.item % nblk, k0 = 64 * kb, n0 = 32 * nb, kr = lane >> 3, nc = (lane & 7) * 4;
#pragma unroll
    for (int i = 0; i < 8; ++i) { v[i] = __builtin_nontemporal_load((const f32x4*)(d.W + (size_t)(k0 + kr + 8 * i) * d.N + n0 + nc)); sc[i] = d.ks ? d.ks[k0 + kr + 8 * i] : 1.0f; }
}
__device__ __forceinline__ void p0_finish(const P0Desc& d, const f32x4 (&v)[8], const float (&sc)[8], LAS float* scr, int lane) {
    const int nblk = d.N / 32, kb = d.item / nblk, nb = d.item % nblk, k0 = 64 * kb, n0 = 32 * nb, kr = lane >> 3, nc = (lane & 7) * 4;
#pragma unroll
    for (int i = 0; i < 8; ++i) { LAS float* p = scr + (kr + 8 * i) * 33 + nc; p[0] = v[i][0] * sc[i]; p[1] = v[i][1] * sc[i]; p[2] = v[i][2] * sc[i]; p[3] = v[i][3] * sc[i]; }
    LDS_WAIT(); asm volatile("" ::: "memory");
    const int c = lane & 7;
    int rb;
    if (d.mode == 0) rb = n0;
    else if (d.mode == 3) rb = (n0 < 5 * HW) ? n0 : ((n0 < 6 * HW) ? 5 * HW + (((n0 - 5 * HW) >> 7) * 256) + ((n0 - 5 * HW) & 127) : 5 * HW + (((n0 - 6 * HW) >> 7) * 256) + 128 + ((n0 - 6 * HW) & 127));
    else rb = (n0 >> 7) * 256 + (d.mode == 2 ? 128 : 0) + (n0 & 127);
#pragma unroll
    for (int j = 0; j < 4; ++j) { const int n = (lane >> 3) + 8 * j; const LAS float* sp = scr + (8 * c) * 33 + n;
        u32x4 o; o.x = pk2(sp[0 * 33], sp[1 * 33]); o.y = pk2(sp[2 * 33], sp[3 * 33]); o.z = pk2(sp[4 * 33], sp[5 * 33]); o.w = pk2(sp[6 * 33], sp[7 * 33]);
        *(u32x4*)(d.WT + (size_t)(rb + n) * d.K + k0 + 8 * c) = o; }
    LDS_WAIT(); asm volatile("" ::: "memory");
}


#define XB_TMO      128
#define XB_XCNT(j)  (256  + 64 * (j))
#define XB_XSUB(j)  (1280 + 64 * (j))
#define XB_XGEN(j)  (2304 + 64 * (j))
#define XB_TOP      3328
#define XB_TOPGEN   3392
#define XCD_BAR_WORDS 3456
#define XB_SPIN_CAP (1u << 18)
__device__ __forceinline__ unsigned xb_ld(unsigned* p)              { return __hip_atomic_load(p, __ATOMIC_RELAXED, __HIP_MEMORY_SCOPE_AGENT); }
__device__ __forceinline__ unsigned xb_add(unsigned* p, unsigned v) { return __hip_atomic_fetch_add(p, v, __ATOMIC_RELAXED, __HIP_MEMORY_SCOPE_AGENT); }
__device__ __forceinline__ unsigned xb_xcc_id() { return (unsigned)__builtin_amdgcn_s_getreg((3 << 11) | 20) & 0xFu; }
#define XB_SPIN(cond, bar) do { unsigned _sp = 0; while (cond) { __builtin_amdgcn_s_sleep(1); \
    if ((++_sp & 255u) == 0u) { if (xb_ld(&(bar)[XB_TMO])) break; if (_sp > XB_SPIN_CAP) { atomicAdd(&(bar)[XB_TMO], 1u); break; } } } } while (0)
struct XcdBarrier { unsigned* bar; unsigned x; volatile LAS unsigned* st; };
__device__ __forceinline__ XcdBarrier xcd_barrier_post(unsigned* bar, volatile LAS unsigned* st) {
    XcdBarrier b; b.bar = bar; b.x = xb_xcc_id(); b.st = st;
    if (threadIdx.x == 0) (void)xb_add(&bar[XB_XCNT(b.x)], 1u);
    return b;
}
__device__ __forceinline__ void xcd_barrier_complete(unsigned* bar, unsigned x, unsigned& nloc, unsigned& nx) {
    const unsigned G = gridDim.x * gridDim.y * gridDim.z;
    unsigned sum, cnt, mine, sp = 0u;
    for (;;) {
        sum = 0u; cnt = 0u; mine = 0u;
#pragma unroll
        for (unsigned j = 0; j < 16; ++j) { const unsigned c = xb_ld(&bar[XB_XCNT(j)]); sum += c; cnt += (c > 0u) ? 1u : 0u; mine = (j == x) ? c : mine; }
        if (sum == G) break;
        __builtin_amdgcn_s_sleep(1);
        if ((++sp & 255u) == 0u) { if (xb_ld(&bar[XB_TMO])) break; if (sp > XB_SPIN_CAP) { atomicAdd(&bar[XB_TMO], 1u); break; } }
    }
    nloc = mine > 0u ? mine : 1u; nx = cnt > 0u ? cnt : 1u;
}
__device__ __forceinline__ void xcd_barrier(const XcdBarrier& b) {
    asm volatile("s_waitcnt vmcnt(0)" ::: "memory");
    __syncthreads();
    if (threadIdx.x == 0) {
        unsigned* bar = b.bar;
        __builtin_amdgcn_s_waitcnt(0);
        unsigned nloc = b.st[0], nx = b.st[1];
        if (nloc == 0u) { xcd_barrier_complete(bar, b.x, nloc, nx); b.st[0] = nloc; b.st[1] = nx; }
        const unsigned old = xb_add(&bar[XB_XSUB(b.x)], 1u);
        const unsigned gen = old / nloc;
        if (old + 1u == (gen + 1u) * nloc) {
            __builtin_amdgcn_fence(__ATOMIC_RELEASE, "agent");
            asm volatile("s_waitcnt vmcnt(0)" ::: "memory");
            const unsigned og = xb_add(&bar[XB_TOP], 1u);
            const unsigned tg = og / nx;
            if (og + 1u == (tg + 1u) * nx) xb_add(&bar[XB_TOPGEN], 1u);
            else XB_SPIN(xb_ld(&bar[XB_TOPGEN]) == tg, bar);
            __builtin_amdgcn_fence(__ATOMIC_ACQUIRE, "agent");
            xb_add(&bar[XB_XGEN(b.x)], 1u);
            asm volatile("s_waitcnt vmcnt(0)" ::: "memory");
        } else {
            XB_SPIN(xb_ld(&bar[XB_XGEN(b.x)]) == gen, bar);
            __builtin_amdgcn_fence(__ATOMIC_ACQUIRE, "agent");
            asm volatile("s_waitcnt vmcnt(0)" ::: "memory");
        }
    }
    __syncthreads();
}


__device__ __forceinline__ void hgrn_p1(LAS unsigned char* lds, bf16_t* PROJ, const float* lbl, bf16_t* OLOC, float* TG, float* CUMG, float* DSEG, int item, int tid_in) {
    int tid = tid_in; asm volatile("" : "+v"(tid));
    constexpr int QS = 272, TS = 144;
    LAS unsigned char* Qd = lds;
    LAS unsigned char* Kd = lds + 17408;
    LAS unsigned char* KsT = lds + 34816;
    LAS unsigned char* VT = KsT + 18432;
    LAS unsigned char* ST = VT + 18432;
    LAS unsigned char* Pm = ST + 34816;
    LAS unsigned char* GT = Pm + 9216;
    LAS unsigned char* DEC = GT + 4096;
    const int lane = tid & 63, w = __builtin_amdgcn_readfirstlane(tid >> 6), r = lane & 15, q = lane >> 4;
    const int b = item >> 5, h = (item >> 2) & 7, g = item & 3;
    const size_t row0 = (size_t)b * SEQ + (size_t)g * 512;
    const int kp = lane, tg = w;
    const int ci = w & 3, vh = w >> 2;
    const float lb0 = sigmoidf_(lbl[h * HD + 2 * kp] - lbl[HW + h * HD + 2 * kp]), lb1 = sigmoidf_(lbl[h * HD + 2 * kp + 1] - lbl[HW + h * HD + 2 * kp + 1]);
    __syncthreads();
    for (int i = tid; i < 34816 / 16; i += 512) *(LAS u32x4*)(ST + i * 16) = (u32x4){0u, 0u, 0u, 0u};
    f32x4 accS[8];
#pragma unroll
    for (int i = 0; i < 8; ++i) accS[i] = (f32x4){0.f, 0.f, 0.f, 0.f};
    char* sbase = (char*)(PROJ + (row0 + 8 * tg) * INC + h * HD);
    const unsigned voff = 4u * (unsigned)kp;
    float cum0 = 1.f, cum1 = 1.f;
    float* cumg = CUMG + ((size_t)(b * 8 + h) * 32 + g * 8) * 128 + 2 * kp;
    unsigned rq[8], rf[8], rv[8];
#pragma unroll
    for (int i = 0; i < 8; ++i) { const char* p = sbase + (size_t)i * INC * 2; rq[i] = *(const unsigned*)(p + voff); rf[i] = *(const unsigned*)(p + HW * 2 + voff); rv[i] = *(const unsigned*)(p + 4 * HW + voff); }
    for (int n = 0; n < 8; ++n) {
        f32x2 fv[8], cpv[8]; f32x2 cc = {1.f, 1.f};
        const f32x2 lbv = {lb0, lb1}, omlb = {1.f - lb0, 1.f - lb1};
#pragma unroll
        for (int i = 0; i < 8; ++i) {
            const f32x2 xv = {bf_lo(rf[i]), bf_hi(rf[i])}; const f32x2 tv = xv * (-1.4426950408889634f);
            f32x2 ev; ev.x = __builtin_amdgcn_exp2f(tv.x); ev.y = __builtin_amdgcn_exp2f(tv.y);
            const f32x2 dv = ev + 1.0f; f32x2 sv; sv.x = __builtin_amdgcn_rcpf(dv.x); sv.y = __builtin_amdgcn_rcpf(dv.y);
            fv[i] = lbv + omlb * sv; cc = cc * fv[i]; cpv[i] = cc;
        }
        *(LAS f32x2*)(GT + (tg * 128 + 2 * kp) * 4) = cc;
        __syncthreads();
        f32x2 prev = {1.f, 1.f}, totv = {1.f, 1.f};
#pragma unroll
        for (int gg = 0; gg < 8; ++gg) { const f32x2 gv = *(const LAS f32x2*)(GT + (gg * 128 + 2 * kp) * 4); if (gg < tg) prev = prev * gv; totv = totv * gv; }
        {
            f32x2 rP[8];
            {   const f32x2 p7 = prev * cpv[7]; rP[7].x = __builtin_amdgcn_rcpf(fmaxf(p7.x, 1e-30f)); rP[7].y = __builtin_amdgcn_rcpf(fmaxf(p7.y, 1e-30f)); }
#pragma unroll
            for (int i = 6; i >= 0; --i) rP[i] = rP[i + 1] * fv[i + 1];
            f32x2 ksv[8];
#pragma unroll
            for (int i = 0; i < 8; ++i) {
                const f32x2 Pv = prev * cpv[i];
                const f32x2 kd = (1.0f - fv[i]) * rP[i];
                const f32x2 qv = {bf_lo(rq[i]), bf_hi(rq[i])}; const f32x2 qdv = qv * Pv;
                const int t = 8 * tg + i;
                const unsigned qd = pg8::cvt_pk_bf16(qdv.x, qdv.y);
                *(LAS unsigned*)(Qd + t * QS + 4 * kp) = qd;
                *(unsigned*)(sbase + (size_t)(n * 64 + i) * INC * 2 + voff) = qd;
                *(LAS unsigned*)(Kd + t * QS + 4 * kp) = pg8::cvt_pk_bf16(kd.x, kd.y);
                ksv[i] = kd * totv;
            }
            u32x4 a0, a1, v0, v1;
            a0.x = pg8::cvt_pk_bf16(ksv[0].x, ksv[1].x); a0.y = pg8::cvt_pk_bf16(ksv[2].x, ksv[3].x); a0.z = pg8::cvt_pk_bf16(ksv[4].x, ksv[5].x); a0.w = pg8::cvt_pk_bf16(ksv[6].x, ksv[7].x);
            a1.x = pg8::cvt_pk_bf16(ksv[0].y, ksv[1].y); a1.y = pg8::cvt_pk_bf16(ksv[2].y, ksv[3].y); a1.z = pg8::cvt_pk_bf16(ksv[4].y, ksv[5].y); a1.w = pg8::cvt_pk_bf16(ksv[6].y, ksv[7].y);
            v0.x = (rv[0] & 0xffffu) | (rv[1] << 16); v0.y = (rv[2] & 0xffffu) | (rv[3] << 16); v0.z = (rv[4] & 0xffffu) | (rv[5] << 16); v0.w = (rv[6] & 0xffffu) | (rv[7] << 16);
            v1.x = (rv[0] >> 16) | (rv[1] & 0xffff0000u); v1.y = (rv[2] >> 16) | (rv[3] & 0xffff0000u); v1.z = (rv[4] >> 16) | (rv[5] & 0xffff0000u); v1.w = (rv[6] >> 16) | (rv[7] & 0xffff0000u);
            *(LAS u32x4*)(KsT + (2 * kp) * TS + 16 * tg) = a0; *(LAS u32x4*)(KsT + (2 * kp + 1) * TS + 16 * tg) = a1;
            *(LAS u32x4*)(VT + (2 * kp) * TS + 16 * tg) = v0; *(LAS u32x4*)(VT + (2 * kp + 1) * TS + 16 * tg) = v1;
            if (tg == 0) { *(LAS f32x2*)(DEC + 8 * kp) = totv; *(f32x2*)(cumg + n * 128) = (f32x2){cum0, cum1}; }
            cum0 *= totv.x; cum1 *= totv.y;
        }
        __syncthreads();
        if (n + 1 < 8) {
#pragma unroll
            for (int i = 0; i < 8; ++i) { const char* p = sbase + (size_t)((n + 1) * 64 + i) * INC * 2; rq[i] = *(const unsigned*)(p + voff); rf[i] = *(const unsigned*)(p + HW * 2 + voff); rv[i] = *(const unsigned*)(p + 4 * HW + voff); }
        }
        {
            const int si = w & 3, c20 = 2 * (w >> 2);
            bf16x8 av[4], b0[4], b1[4];
            if (si <= c20 + 1) {
#pragma unroll
                for (int kk = 0; kk < 4; ++kk) { av[kk] = *(const LAS bf16x8*)(Kd + (16 * si + r) * QS + (32 * kk + 8 * q) * 2);
                    b0[kk] = *(const LAS bf16x8*)(Qd + (16 * c20 + r) * QS + (32 * kk + 8 * q) * 2); b1[kk] = *(const LAS bf16x8*)(Qd + (16 * (c20 + 1) + r) * QS + (32 * kk + 8 * q) * 2); }
            }
            __builtin_amdgcn_sched_barrier(0);
            f32x4 acc0 = (f32x4){0.f, 0.f, 0.f, 0.f}, acc1 = (f32x4){0.f, 0.f, 0.f, 0.f};
            if (si <= c20 + 1) {
#pragma unroll
                for (int kk = 0; kk < 4; ++kk) { acc0 = __builtin_amdgcn_mfma_f32_16x16x32_bf16(av[kk], b0[kk], acc0, 0, 0, 0); acc1 = __builtin_amdgcn_mfma_f32_16x16x32_bf16(av[kk], b1[kk], acc1, 0, 0, 0); }
            }
#pragma unroll
            for (int j = 0; j < 4; ++j) { if (si > c20 || (si == c20 && 4 * q + j > r)) acc0[j] = 0.f; if (si == c20 + 1 && 4 * q + j > r) acc1[j] = 0.f; }
            u32x2 pw; pw.x = pg8::cvt_pk_bf16(acc0[0], acc0[1]); pw.y = pg8::cvt_pk_bf16(acc0[2], acc0[3]);
            *(LAS u32x2*)(Pm + (16 * c20 + r) * TS + (16 * si + 4 * q) * 2) = pw;
            pw.x = pg8::cvt_pk_bf16(acc1[0], acc1[1]); pw.y = pg8::cvt_pk_bf16(acc1[2], acc1[3]);
            *(LAS u32x2*)(Pm + (16 * (c20 + 1) + r) * TS + (16 * si + 4 * q) * 2) = pw;
        }
        __syncthreads();
        {
            bf16x8 pa[2], qa[4], bb[6];
#pragma unroll
            for (int kk = 0; kk < 2; ++kk) pa[kk] = *(const LAS bf16x8*)(Pm + (16 * ci + r) * TS + (32 * kk + 8 * q) * 2);
#pragma unroll
            for (int kk = 0; kk < 4; ++kk) qa[kk] = *(const LAS bf16x8*)(Qd + (16 * ci + r) * QS + (32 * kk + 8 * q) * 2);
            bf16_t* op = OLOC + (row0 + (size_t)n * 64 + 16 * ci + r) * HW + h * HD + 64 * vh + 4 * q;
#pragma unroll
            for (int i = 0; i < 4; ++i) {
                const int vt = 4 * vh + i;
#pragma unroll
                for (int kk = 0; kk < 2; ++kk) bb[kk] = *(const LAS bf16x8*)(VT + (16 * vt + r) * TS + (32 * kk + 8 * q) * 2);
#pragma unroll
                for (int kk = 0; kk < 4; ++kk) bb[2 + kk] = *(const LAS bf16x8*)(ST + (16 * vt + r) * QS + (32 * kk + 8 * q) * 2);
                __builtin_amdgcn_sched_barrier(0);
                f32x4 acc = (f32x4){0.f, 0.f, 0.f, 0.f};
#pragma unroll
                for (int kk = 0; kk < 2; ++kk) acc = __builtin_amdgcn_mfma_f32_16x16x32_bf16(bb[kk], pa[kk], acc, 0, 0, 0);
#pragma unroll
                for (int kk = 0; kk < 4; ++kk) acc = __builtin_amdgcn_mfma_f32_16x16x32_bf16(bb[2 + kk], qa[kk], acc, 0, 0, 0);
                { u32x2 ow; ow.x = pg8::cvt_pk_bf16(acc[0], acc[1]); ow.y = pg8::cvt_pk_bf16(acc[2], acc[3]); *(u32x2*)(op + 16 * i) = ow; }
                __builtin_amdgcn_sched_barrier(0);
            }
        }
        __syncthreads();
        {
            const f32x4 dkc = *(const LAS f32x4*)(DEC + (16 * w + 4 * q) * 4);
            bf16x8 ka[2], vb[8];
#pragma unroll
            for (int kk = 0; kk < 2; ++kk) ka[kk] = *(const LAS bf16x8*)(KsT + (16 * w + r) * TS + (32 * kk + 8 * q) * 2);
#pragma unroll
            for (int hf = 0; hf < 2; ++hf) {
#pragma unroll
                for (int t4 = 0; t4 < 4; ++t4)
#pragma unroll
                    for (int kk = 0; kk < 2; ++kk) vb[2 * t4 + kk] = *(const LAS bf16x8*)(VT + (16 * (4 * hf + t4) + r) * TS + (32 * kk + 8 * q) * 2);
                __builtin_amdgcn_sched_barrier(0);
#pragma unroll
                for (int t4 = 0; t4 < 4; ++t4) {
                    const int ni = 4 * hf + t4;
                    f32x4 acc = accS[ni] * dkc;
#pragma unroll
                    for (int kk = 0; kk < 2; ++kk) acc = __builtin_amdgcn_mfma_f32_16x16x32_bf16(ka[kk], vb[2 * t4 + kk], acc, 0, 0, 0);
                    accS[ni] = acc;
                }
                __builtin_amdgcn_sched_barrier(0);
            }
#pragma unroll
            for (int ni = 0; ni < 8; ++ni) { u32x2 sw; sw.x = pg8::cvt_pk_bf16(accS[ni][0], accS[ni][1]); sw.y = pg8::cvt_pk_bf16(accS[ni][2], accS[ni][3]);
                *(LAS u32x2*)(ST + (16 * ni + r) * QS + (16 * w + 4 * q) * 2) = sw; }
        }
    }
    {   f32x4* tg4 = (f32x4*)TG + ((size_t)item * 8 + w) * 8 * 64 + lane;
#pragma unroll
        for (int ni = 0; ni < 8; ++ni) tg4[ni * 64] = accS[ni];
        if (tg == 0) *(f32x2*)(DSEG + (size_t)item * 128 + 2 * kp) = (f32x2){cum0, cum1};
    }
    __syncthreads();
}

__device__ __forceinline__ void hgrn_p2(LAS unsigned char* lds, const bf16_t* PROJ, const bf16_t* OLOC, const float* TG, const float* CUMG, const float* DSEG, const float* nw, bf16_t* MIX, int item, int tid_in) {
    int tid = tid_in; asm volatile("" : "+v"(tid));
    constexpr int QS = 272;
    LAS unsigned char* Qd = lds;
    LAS unsigned char* ST = lds + 17408;
    LAS unsigned char* NRM = ST + 34816;
    LAS unsigned char* OT = NRM + 2048;
    const int lane = tid & 63, w = __builtin_amdgcn_readfirstlane(tid >> 6), r = lane & 15, q = lane >> 4;
    const int b = item >> 5, h = (item >> 2) & 7, g = item & 3;
    const size_t row0 = (size_t)b * SEQ + (size_t)g * 512;
    const int ci = w & 3, vh = w >> 2;
    f32x4 sin[8];
#pragma unroll
    for (int i = 0; i < 8; ++i) sin[i] = (f32x4){0.f, 0.f, 0.f, 0.f};
    for (int gp = 0; gp < g; ++gp) {
        const int it2 = item - g + gp;
        const f32x4 ds = *(const f32x4*)(DSEG + (size_t)it2 * 128 + 16 * w + 4 * q);
        const f32x4* tg4 = (const f32x4*)TG + ((size_t)it2 * 8 + w) * 8 * 64 + lane;
#pragma unroll
        for (int ni = 0; ni < 8; ++ni) sin[ni] = sin[ni] * ds + tg4[ni * 64];
    }
    const float* cumg = CUMG + ((size_t)(b * 8 + h) * 32 + g * 8) * 128 + 16 * w + 4 * q;
    const char* qbase = (const char*)(PROJ + row0 * INC + h * HD);
    const unsigned qoff = (unsigned)(tid >> 4) * (INC * 2) + (unsigned)(tid & 15) * 16u;
    const char* gbase = (const char*)(PROJ + (row0 + 16 * ci) * INC + 3 * HW + h * HD + 64 * vh);
    const unsigned go = (unsigned)r * (INC * 2) + 8u * (unsigned)q;
    const float* nwp = nw + h * HD + 64 * vh + 4 * q;
    f32x4 nv[4];
#pragma unroll
    for (int i = 0; i < 4; ++i) nv[i] = *(const f32x4*)(nwp + 16 * i);
    u32x4 lq[2]; u32x2 lo[4], gt[4]; f32x4 cmn;
#define HP2_LOAD(nn) do { \
        if (g > 0) { _Pragma("unroll") for (int j = 0; j < 2; ++j) lq[j] = *(const u32x4*)(qbase + (size_t)((nn) * 64 + 32 * j) * INC * 2 + qoff); cmn = *(const f32x4*)(cumg + (nn) * 128); } \
        const bf16_t* op_ = OLOC + (row0 + (size_t)(nn) * 64 + 16 * ci + r) * HW + h * HD + 64 * vh + 4 * q; \
        _Pragma("unroll") for (int i = 0; i < 4; ++i) { lo[i] = *(const u32x2*)(op_ + 16 * i); gt[i] = *(const u32x2*)(gbase + (size_t)(nn) * 64 * INC * 2 + (size_t)(32 * i) + go); } \
    } while (0)
    HP2_LOAD(0);
    __syncthreads();
    for (int n = 0; n < 8; ++n) {
        f32x4 o[4]; u32x2 gc[4];
#pragma unroll
        for (int i = 0; i < 4; ++i) { o[i] = (f32x4){bf_lo(lo[i].x), bf_hi(lo[i].x), bf_lo(lo[i].y), bf_hi(lo[i].y)}; gc[i] = gt[i]; }
        if (g > 0) {
            const f32x4 cm = cmn;
#pragma unroll
            for (int ni = 0; ni < 8; ++ni) { const f32x4 sv = sin[ni] * cm; u32x2 sw; sw.x = pg8::cvt_pk_bf16(sv[0], sv[1]); sw.y = pg8::cvt_pk_bf16(sv[2], sv[3]);
                *(LAS u32x2*)(ST + (16 * ni + r) * QS + (16 * w + 4 * q) * 2) = sw; }
#pragma unroll
            for (int j = 0; j < 2; ++j) { const int t = (tid >> 4) + 32 * j, c = tid & 15; *(LAS u32x4*)(Qd + t * QS + c * 16) = lq[j]; }
        }
        __syncthreads();
        if (n + 1 < 8) HP2_LOAD(n + 1);
        if (g > 0) {
            bf16x8 qa[4], bb[4];
#pragma unroll
            for (int kk = 0; kk < 4; ++kk) qa[kk] = *(const LAS bf16x8*)(Qd + (16 * ci + r) * QS + (32 * kk + 8 * q) * 2);
#pragma unroll
            for (int i = 0; i < 4; ++i) {
#pragma unroll
                for (int kk = 0; kk < 4; ++kk) bb[kk] = *(const LAS bf16x8*)(ST + (16 * (4 * vh + i) + r) * QS + (32 * kk + 8 * q) * 2);
                __builtin_amdgcn_sched_barrier(0);
                f32x4 acc = o[i];
#pragma unroll
                for (int kk = 0; kk < 4; ++kk) acc = __builtin_amdgcn_mfma_f32_16x16x32_bf16(bb[kk], qa[kk], acc, 0, 0, 0);
                o[i] = acc;
                __builtin_amdgcn_sched_barrier(0);
            }
        }
        {
            float sq = 0.f;
#pragma unroll
            for (int i = 0; i < 4; ++i) sq += (o[i][0] * o[i][0] + o[i][1] * o[i][1]) + (o[i][2] * o[i][2] + o[i][3] * o[i][3]);
            *(LAS float*)(NRM + ((vh * 4 + q) * 64 + 16 * ci + r) * 4) = sq;
        }
        __syncthreads();
        {
            float ssum = 0.f;
#pragma unroll
            for (int gg = 0; gg < 8; ++gg) ssum += *(const LAS float*)(NRM + (gg * 64 + 16 * ci + r) * 4);
            const float rs = __builtin_amdgcn_rsqf(ssum * (1.0f / HD) + EPS);
            LAS unsigned char* ot = OT + w * 2304;
#pragma unroll
            for (int i = 0; i < 4; ++i) {
                const float g0 = bf_lo(gc[i].x), g1 = bf_hi(gc[i].x), g2 = bf_lo(gc[i].y), g3 = bf_hi(gc[i].y);
                u32x2 ow; ow.x = pg8::cvt_pk_bf16(o[i][0] * rs * nv[i][0] * siluf_(g0), o[i][1] * rs * nv[i][1] * siluf_(g1));
                ow.y = pg8::cvt_pk_bf16(o[i][2] * rs * nv[i][2] * siluf_(g2), o[i][3] * rs * nv[i][3] * siluf_(g3));
                *(LAS u32x2*)(ot + r * 144 + (16 * i + 4 * q) * 2) = ow;
            }
            asm volatile("s_waitcnt lgkmcnt(0)" ::: "memory");
#pragma unroll
            for (int j = 0; j < 2; ++j) { const int rr = (lane >> 3) + 8 * j, pc = lane & 7;
                const u32x4 ov = *(const LAS u32x4*)(ot + rr * 144 + pc * 16);
                *(u32x4*)(MIX + (row0 + (size_t)n * 64 + 16 * ci + rr) * D + h * HD + 64 * vh + pc * 8) = ov; }
        }
        __syncthreads();
    }
#undef HP2_LOAD
}

struct Args { const float* in[16]; float* out; unsigned char* ws; int use_cg; int pad; };

__global__ void __launch_bounds__(512, 2) mk_fwd(Args a) {
    extern __shared__ __attribute__((aligned(16))) unsigned char lds_raw[];
    LAS unsigned char* lds = (LAS unsigned char*)lds_raw;
    cg::grid_group grid = cg::this_grid();
    const int tid = threadIdx.x, lane = tid & 63, wave = __builtin_amdgcn_readfirstlane(tid >> 6);
    const int G = gridDim.x, bid = blockIdx.x;
    unsigned char* ws = a.ws;
    float* ssq0 = (float*)(ws + WS_SSQ); float* ssq1 = ssq0 + M; float* ssq2 = ssq1 + M; float* ssq3 = ssq2 + M;
    float* ssqh = (float*)(ws + WS_SSQH);
    bf16_t* W1GU = (bf16_t*)(ws + WS_W1GU); bf16_t* W1D = (bf16_t*)(ws + WS_W1D); bf16_t* WIN = (bf16_t*)(ws + WS_WIN); bf16_t* WOUT = (bf16_t*)(ws + WS_WOUT);
    bf16_t* W2GU = (bf16_t*)(ws + WS_W2GU); bf16_t* W2D = (bf16_t*)(ws + WS_W2D);
    bf16_t* MIX = (bf16_t*)(ws + WS_MIX); bf16_t* XB = (bf16_t*)(ws + WS_XB); float* OUN = (float*)(ws + WS_XB);
    bf16_t* HB = (bf16_t*)(ws + WS_BIG); bf16_t* PROJ = (bf16_t*)(ws + WS_BIG);
    bf16_t* OLOC = (bf16_t*)a.out;
    float* OLOC_unused = (float*)(ws + WS_XB); (void)OLOC_unused; float* TGS = (float*)(ws + WS_TG); float* CUMG = (float*)(ws + WS_CUM); float* DSEG = (float*)(ws + WS_DSEG);
    const float* x = a.in[0]; float* out = a.out;
    if (tid < 64) ((LAS unsigned*)(lds + LDS_CTL))[tid] = 0u;
    __syncthreads();
    const XcdBarrier xbar = xcd_barrier_post((unsigned*)(ws + WS_BAR), (volatile LAS unsigned*)(lds + LDS_CTL + 32));
#define GRID_BAR() do { if (a.use_cg) grid.sync(); else xcd_barrier(xbar); } while (0)

    {
        LAS float* scr = (LAS float*)(lds + wave * 16384);
        const int gw = bid * 8 + wave, NGW = G * 8;
        constexpr int I_GU = (D / 64) * (FF / 32), I_DN = (FF / 64) * (D / 32), I_IN = (D / 64) * (INC / 32), I_OUT = (D / 64) * (D / 32);
        constexpr int NITEMS = 4 * I_GU + 2 * I_DN + I_IN + I_OUT;
        auto desc = [&](int it) -> P0Desc {
            int r = it;
            if (r < I_GU) return P0Desc{a.in[2], W1GU, a.in[1], D, FF, 1, r}; r -= I_GU;
            if (r < I_GU) return P0Desc{a.in[3], W1GU, a.in[1], D, FF, 2, r}; r -= I_GU;
            if (r < I_DN) return P0Desc{a.in[4], W1D, nullptr, FF, D, 0, r}; r -= I_DN;
            if (r < I_IN) return P0Desc{a.in[6], WIN, a.in[5], D, INC, 3, r}; r -= I_IN;
            if (r < I_OUT) return P0Desc{a.in[10], WOUT, nullptr, D, D, 0, r}; r -= I_OUT;
            if (r < I_GU) return P0Desc{a.in[12], W2GU, a.in[11], D, FF, 1, r}; r -= I_GU;
            if (r < I_GU) return P0Desc{a.in[13], W2GU, a.in[11], D, FF, 2, r}; r -= I_GU;
            return P0Desc{a.in[14], W2D, nullptr, FF, D, 0, r};
        };
        {
            f32x4 va[8], vb[8]; float sa[8], sb[8];
            int it = gw;
            P0Desc da = desc(it < NITEMS ? it : 0), db = da;
            if (it < NITEMS) p0_load(da, va, sa, lane);
            while (it < NITEMS) {
                const int itb = it + NGW;
                if (itb < NITEMS) { db = desc(itb); p0_load(db, vb, sb, lane); }
                p0_finish(da, va, sa, scr, lane);
                if (itb >= NITEMS) break;
                const int ita = itb + NGW;
                if (ita < NITEMS) { da = desc(ita); p0_load(da, va, sa, lane); }
                p0_finish(db, vb, sb, scr, lane);
                it = ita;
            }
        }
        for (int m = gw; m < M; m += NGW) {
            const f32x4* xr = (const f32x4*)(x + (size_t)m * D) + lane; u32x2* o8 = (u32x2*)(XB + (size_t)m * D) + lane; float s = 0.f;
#pragma unroll
            for (int j = 0; j < 8; ++j) { const f32x4 v = xr[64 * j]; s += (v[0] * v[0] + v[1] * v[1]) + (v[2] * v[2] + v[3] * v[3]); u32x2 w; w.x = pk2(v[0], v[1]); w.y = pk2(v[2], v[3]); o8[64 * j] = w; }
            s = wave_sum(s);
            if (lane == 0) ssq0[m] = s;
        }
        for (int i = bid * 512 + tid; i < 3 * M; i += G * 512) ssq1[i] = 0.f;
    }
    GRID_BAR();

    { pg8::Gemm g{XB, W1GU, M, 2 * FF, D}; pg8::StaticOrder S; S.init(M, 2 * FF, G, bid); pg8::EpiSwiGLU E{HB, ssq0}; pg8::gemm_phase<pg8::EpiSwiGLU>(lds, g, S, E); }
    GRID_BAR();
    { pg8::Gemm g{HB, W1D, M, D, FF}; pg8::StaticOrder S; S.init(M, D, G, bid); pg8::EpiResid<true, true> E{nullptr, XB, nullptr, XB, ssq1, 0.5f}; pg8::gemm_phase<pg8::EpiResid<true, true>>(lds, g, S, E); }
    GRID_BAR();
    { pg8::Gemm g{XB, WIN, M, INC, D}; pg8::StaticOrder S; S.init(M, INC, G, bid); pg8::EpiProj E{PROJ, ssq1}; pg8::gemm_phase<pg8::EpiProj>(lds, g, S, E); }
    GRID_BAR();

    for (int item = bid; item < 256; item += G) hgrn_p1(lds, PROJ, a.in[7], OLOC, TGS, CUMG, DSEG, item, tid);
    {
        const float* cw = a.in[9];
        const size_t stride = (size_t)G * 512, total = (size_t)M * 128;
        const int c0 = (tid & 127) * 8;
        f32x4 wa[3], wb[3];
#pragma unroll
        for (int d = 0; d < 3; ++d) { wa[d] = *(const f32x4*)(cw + d * HW + c0); wb[d] = *(const f32x4*)(cw + d * HW + c0 + 4); }
        for (size_t idx0 = (size_t)bid * 512 + tid; idx0 < total; idx0 += 2 * stride) {
            u32x4 bb[2], cc[2][3]; float ok[2][3]; size_t rows[2]; bool have[2];
#pragma unroll
            for (int u = 0; u < 2; ++u) {
                const size_t idx = idx0 + u * stride; have[u] = idx < total;
                const size_t row = have[u] ? (idx >> 7) : (idx0 >> 7); rows[u] = row; const int t = (int)(row & (SEQ - 1));
                const bf16_t* pr = PROJ + row * INC;
                bb[u] = *(const u32x4*)(pr + 4 * HW + c0);
#pragma unroll
                for (int d = 0; d < 3; ++d) { const bool v = (t - 2 + d) >= 0; ok[u][d] = v ? 1.f : 0.f; const bf16_t* p2 = v ? pr - (size_t)(2 - d) * INC : pr;
                    cc[u][d] = *(const u32x4*)(p2 + 5 * HW + c0); }
            }
#pragma unroll
            for (int u = 0; u < 2; ++u) {
                float acc8[8];
#pragma unroll
                for (int j = 0; j < 8; ++j) acc8[j] = 0.f;
#pragma unroll
                for (int d = 0; d < 3; ++d) {
                    const u32x4 c4 = cc[u][d]; const float m = ok[u][d];
                    const float cv[8] = {bf_lo(c4.x), bf_hi(c4.x), bf_lo(c4.y), bf_hi(c4.y), bf_lo(c4.z), bf_hi(c4.z), bf_lo(c4.w), bf_hi(c4.w)};
#pragma unroll
                    for (int j = 0; j < 4; ++j) { acc8[j] += (wa[d][j] * m) * cv[j]; acc8[4 + j] += (wb[d][j] * m) * cv[4 + j]; }
                }
                const u32x4 b4 = bb[u];
                const float bv[8] = {bf_lo(b4.x), bf_hi(b4.x), bf_lo(b4.y), bf_hi(b4.y), bf_lo(b4.z), bf_hi(b4.z), bf_lo(b4.w), bf_hi(b4.w)};
                u32x4 w; w.x = pk2(bv[0] * acc8[0], bv[1] * acc8[1]); w.y = pk2(bv[2] * acc8[2], bv[3] * acc8[3]); w.z = pk2(bv[4] * acc8[4], bv[5] * acc8[5]); w.w = pk2(bv[6] * acc8[6], bv[7] * acc8[7]);
                if (have[u]) *(u32x4*)(MIX + rows[u] * D + HW + c0) = w;
            }
        }
    }
    GRID_BAR();
    for (int item = bid; item < 256; item += G) hgrn_p2(lds, PROJ, OLOC, TGS, CUMG, DSEG, a.in[8], MIX, item, tid);
    GRID_BAR();


    { pg8::Gemm g{MIX, WOUT, M, D, D}; pg8::StaticOrder S; S.init(M, D, G, bid); pg8::EpiResid<true, true> E{nullptr, XB, nullptr, XB, ssq2, 1.0f}; pg8::gemm_phase<pg8::EpiResid<true, true>>(lds, g, S, E); }
    GRID_BAR();
    { pg8::Gemm g{XB, W2GU, M, 2 * FF, D}; pg8::StaticOrder S; S.init(M, 2 * FF, G, bid); pg8::EpiSwiGLU E{HB, ssq2}; pg8::gemm_phase<pg8::EpiSwiGLU>(lds, g, S, E); }
    GRID_BAR();
    { pg8::Gemm g{HB, W2D, M, D, FF}; pg8::StaticOrder S; S.init(M, D, G, bid); pg8::EpiResid<true, true> E{nullptr, XB, nullptr, XB, ssq3, 0.5f}; pg8::gemm_phase<pg8::EpiResid<true, true>>(lds, g, S, E); }
    GRID_BAR();
    {
        const float* fw = a.in[15];
        for (size_t idx = (size_t)bid * 512 + tid; idx < (size_t)M * (D / 8); idx += (size_t)G * 512) {
            const size_t row = idx >> 8; const int c8 = (int)(idx & 255) * 8;
            const float rs = __builtin_amdgcn_rsqf(ssq3[row] * (1.0f / D) + EPS);
            const u32x4 xv = *(const u32x4*)(XB + row * D + c8); const f32x4 w0 = *(const f32x4*)(fw + c8), w1 = *(const f32x4*)(fw + c8 + 4);
            const f32x4 v0 = (f32x4){bf_lo(xv.x), bf_hi(xv.x), bf_lo(xv.y), bf_hi(xv.y)}, v1 = (f32x4){bf_lo(xv.z), bf_hi(xv.z), bf_lo(xv.w), bf_hi(xv.w)};
            *(f32x4*)(out + row * D + c8) = v0 * rs * w0; *(f32x4*)(out + row * D + c8 + 4) = v1 * rs * w1;
        }
    }
}

extern "C" void kernel_launch(void* const* d_in, const int* in_sizes, int n_in, void* d_out, int out_size,
                              void* d_ws, size_t ws_size, hipStream_t stream) {
    static int grid = 0;
    if (grid == 0) {
        if (n_in != 16 || in_sizes[0] != M * D || out_size != M * D || ws_size < WS_END) { fprintf(stderr, "kernel_launch: unexpected shapes / workspace (%d inputs, ws %zu)\n", n_in, ws_size); grid = -1; return; }
        int dev = 0, cus = 0, per_cu = 0;
        (void)hipGetDevice(&dev);
        (void)hipDeviceGetAttribute(&cus, hipDeviceAttributeMultiprocessorCount, dev);
        (void)hipFuncSetAttribute((const void*)mk_fwd, hipFuncAttributeMaxDynamicSharedMemorySize, LDS_BYTES);
        (void)hipOccupancyMaxActiveBlocksPerMultiprocessor(&per_cu, (const void*)mk_fwd, 512, LDS_BYTES);
        if (per_cu < 1) { fprintf(stderr, "kernel_launch: occupancy query says %d\n", per_cu); per_cu = 1; }
        grid = cus * per_cu;
    }
    if (grid < 0) return;
    Args a{};
    for (int i = 0; i < 16; ++i) a.in[i] = (const float*)d_in[i];
    a.out = (float*)d_out; a.ws = (unsigned char*)d_ws; a.use_cg = 0; a.pad = 0;
    if (hipMemsetAsync((char*)d_ws + WS_BAR, 0, BAR_BYTES, stream) != hipSuccess) { fprintf(stderr, "kernel_launch: memset failed\n"); return; }
    void* args[] = {&a};
    hipError_t e = hipLaunchCooperativeKernel((const void*)mk_fwd, dim3(grid), dim3(512), args, LDS_BYTES, stream);
    if (e != hipSuccess) fprintf(stderr, "cooperative launch failed: %s (grid %d)\n", hipGetErrorString(e), grid);
}
```

```cpp
#include <hip/hip_runtime.h>
#include <hip/hip_cooperative_groups.h>
#include <cstdio>
#include <cstdint>
namespace cg = cooperative_groups;

#define LAS __attribute__((address_space(3)))
typedef unsigned short bf16_t;
typedef short bf16x8 __attribute__((ext_vector_type(8)));
typedef float f32x4 __attribute__((ext_vector_type(4)));
typedef float f32x2 __attribute__((ext_vector_type(2)));
typedef unsigned u32x4 __attribute__((ext_vector_type(4)));
typedef unsigned u32x2 __attribute__((ext_vector_type(2)));

constexpr int D = 2048, M = 16384, SEQ = 2048, FF = 5632, HW = 1024, NHEAD = 8, HD = 128, INC = 7168;
constexpr float EPS = 1e-6f;
constexpr size_t MiB = 1u << 20;
constexpr size_t WS_SSQ = 0;
constexpr size_t WS_BAR = 1 * MiB, BAR_BYTES = 16384;
constexpr size_t WS_SSQH = 2 * MiB;
constexpr size_t WS_W1GU = 4 * MiB, WS_W1D = 48 * MiB, WS_WIN = 70 * MiB, WS_WOUT = 98 * MiB, WS_W2GU = 106 * MiB, WS_W2D = 150 * MiB;
constexpr size_t WS_MIX = 4 * MiB;
constexpr size_t WS_XB = 172 * MiB;
constexpr size_t WS_BIG = 236 * MiB;
constexpr size_t WS_TG = 460 * MiB;
constexpr size_t WS_CUM = 476 * MiB;
constexpr size_t WS_DSEG = 477 * MiB;
constexpr size_t WS_END = 478 * MiB;
constexpr int LDS_BYTES = 147456, LDS_CTL = 131072;

__device__ __forceinline__ unsigned f2bf(float f) { unsigned u = __builtin_bit_cast(unsigned, f); return (u + 0x7fffu + ((u >> 16) & 1u)) >> 16; }
__device__ __forceinline__ unsigned pk2(float lo, float hi) { return f2bf(lo) | (f2bf(hi) << 16); }
__device__ __forceinline__ float bf_lo(unsigned w) { return __builtin_bit_cast(float, w << 16); }
__device__ __forceinline__ float bf_hi(unsigned w) { return __builtin_bit_cast(float, w & 0xffff0000u); }
__device__ __forceinline__ float sigmoidf_(float x) { return __builtin_amdgcn_rcpf(1.0f + __builtin_amdgcn_exp2f(-1.4426950408889634f * x)); }
__device__ __forceinline__ float siluf_(float x) { return x * sigmoidf_(x); }

namespace pg8 {
constexpr int BM = 256, BK = 64, HALF = 128, HTB = HALF * BK * 2, STAGE_BYTES = 8 * HTB, NXCD = 8, WGM = 4;
__host__ __device__ __forceinline__ int lds_byte(int r, int c) { const int st = (r >> 4) * 2 + (c >> 5), rr = r & 15, cc = c & 31, ob = rr * 64 + cc * 2; return st * 1024 + (ob ^ (((ob >> 9) & 1) << 5)); }
__host__ __device__ __forceinline__ void stage_rc(int b, int& R, int& C) { const int st = b / 1024, sb = b % 1024, swz = sb ^ (((sb >> 9) & 1) << 5); R = (st >> 1) * 16 + swz / 64; C = (st & 1) * 32 + (swz % 64) / 2; }
__host__ __device__ __forceinline__ int perm32(int rho) { const int n = rho >> 4, i = rho & 15; return 8 * (i >> 2) + 4 * n + (i & 3); }

struct Unit { int pm, pn; };
struct Gemm { const bf16_t* A; const bf16_t* Bt; int M, N, K; };

struct StaticOrder {
    int nM, nN, nwg, G, c;
    __host__ __device__ void init(int M_, int N_, int G_, int c_) { nM = M_ / BM; nN = N_ / BM; nwg = nM * nN; G = G_; c = c_; }
    __host__ __device__ bool next(int i, Unit& u) const {
        const long L = (long)i * G + c; if (L >= nwg) return false;
        int wgid = (int)L; { const int q = nwg / NXCD, r = nwg % NXCD, xcd = wgid % NXCD, off = wgid / NXCD; wgid = (xcd < r ? xcd * (q + 1) : r * (q + 1) + (xcd - r) * q) + off; }
        const int nig = WGM * nN, gid = wgid / nig, fm = gid * WGM, gsz = (nM - fm) < WGM ? (nM - fm) : WGM;
        u.pm = fm + ((wgid % nig) % gsz); u.pn = (wgid % nig) / gsz; return true;
    }
};

typedef __bf16 bf16x2_t __attribute__((ext_vector_type(2)));
__device__ __forceinline__ unsigned cvt_pk_bf16(float lo, float hi) { const f32x2 v = {lo, hi}; const bf16x2_t b = __builtin_convertvector(v, bf16x2_t); return __builtin_bit_cast(unsigned, b); }

struct EpiSwiGLU {
    static constexpr bool PERM = true;
    bf16_t* O; const float* ssq;
    __device__ __forceinline__ void operator()(const f32x4 (&acc)[2][2][4][2], const Unit& u, int wr, int wc, int fr, int fq) const {
        const int row0 = u.pm * BM + wr * 64 + fr, col0 = u.pn * HALF + wc * 32 + 8 * fq;
        float rsv[2][4];
#pragma unroll
        for (int ai = 0; ai < 2; ++ai)
#pragma unroll
            for (int m = 0; m < 4; ++m) rsv[ai][m] = ssq[row0 + ai * HALF + m * 16];
        __builtin_amdgcn_sched_barrier(0);
#pragma unroll
        for (int ai = 0; ai < 2; ++ai)
#pragma unroll
            for (int m = 0; m < 4; ++m) {
                const int row = row0 + ai * HALF + m * 16;
                const float rs = __builtin_amdgcn_rsqf(rsv[ai][m] * (1.0f / D) + EPS);
                f32x4 h0, h1;
#pragma unroll
                for (int j = 0; j < 4; ++j) { h0[j] = siluf_(acc[ai][0][m][0][j] * rs) * (acc[ai][1][m][0][j] * rs); h1[j] = siluf_(acc[ai][0][m][1][j] * rs) * (acc[ai][1][m][1][j] * rs); }
                u32x4 w; w.x = cvt_pk_bf16(h0[0], h0[1]); w.y = cvt_pk_bf16(h0[2], h0[3]); w.z = cvt_pk_bf16(h1[0], h1[1]); w.w = cvt_pk_bf16(h1[2], h1[3]);
                __builtin_nontemporal_store(w, (u32x4*)(O + (size_t)row * FF + col0));
            }
    }
};
struct EpiProj {
    static constexpr bool PERM = true;
    bf16_t* O; const float* ssq;
    __device__ __forceinline__ void operator()(const f32x4 (&acc)[2][2][4][2], const Unit& u, int wr, int wc, int fr, int fq) const {
        const int row0 = u.pm * BM + wr * 64 + fr, col0 = u.pn * BM + wc * 32 + 8 * fq;
        float rsv[2][4];
#pragma unroll
        for (int ai = 0; ai < 2; ++ai)
#pragma unroll
            for (int m = 0; m < 4; ++m) rsv[ai][m] = ssq[row0 + ai * HALF + m * 16];
        __builtin_amdgcn_sched_barrier(0);
#pragma unroll
        for (int ai = 0; ai < 2; ++ai)
#pragma unroll
            for (int m = 0; m < 4; ++m) {
                const int row = row0 + ai * HALF + m * 16;
                const float rs = __builtin_amdgcn_rsqf(rsv[ai][m] * (1.0f / D) + EPS);
                if (u.pn >= 20) {
                    const float rs2 = rs * rs;
                    const f32x4 v0 = acc[ai][0][m][0] * acc[ai][1][m][0] * rs2, v1 = acc[ai][0][m][1] * acc[ai][1][m][1] * rs2;
                    u32x4 w; w.x = cvt_pk_bf16(v0[0], v0[1]); w.y = cvt_pk_bf16(v0[2], v0[3]); w.z = cvt_pk_bf16(v1[0], v1[1]); w.w = cvt_pk_bf16(v1[2], v1[3]);
                    *(u32x4*)(O + (size_t)row * INC + 5 * HW + (u.pn - 20) * HALF + wc * 32 + 8 * fq) = w;
                } else {
#pragma unroll
                for (int bj = 0; bj < 2; ++bj) { const f32x4 v0 = acc[ai][bj][m][0] * rs, v1 = acc[ai][bj][m][1] * rs;
                    u32x4 w; w.x = cvt_pk_bf16(v0[0], v0[1]); w.y = cvt_pk_bf16(v0[2], v0[3]); w.z = cvt_pk_bf16(v1[0], v1[1]); w.w = cvt_pk_bf16(v1[2], v1[3]);
                    *(u32x4*)(O + (size_t)row * INC + col0 + bj * HALF) = w; }
                }
            }
    }
};
template <bool BASE_BF, bool OUT_BF> struct EpiResid {
    static constexpr bool PERM = true;
    const float* basef; const bf16_t* baseb; float* outf; bf16_t* outb; float* ssq; float scale;
    __device__ __forceinline__ void operator()(const f32x4 (&acc)[2][2][4][2], const Unit& u, int wr, int wc, int fr, int fq) const {
        const int row0 = u.pm * BM + wr * 64 + fr, col0 = u.pn * BM + wc * 32 + 8 * fq;
#pragma unroll
        for (int ai = 0; ai < 2; ++ai) {
            f32x4 b[4][2][2];
#pragma unroll
            for (int m = 0; m < 4; ++m) { const size_t off = (size_t)(row0 + ai * HALF + m * 16) * D + col0;
#pragma unroll
                for (int bj = 0; bj < 2; ++bj) {
                    if (BASE_BF) { const u32x4 w = *(const u32x4*)(baseb + off + bj * HALF);
                        b[m][bj][0] = (f32x4){bf_lo(w.x), bf_hi(w.x), bf_lo(w.y), bf_hi(w.y)}; b[m][bj][1] = (f32x4){bf_lo(w.z), bf_hi(w.z), bf_lo(w.w), bf_hi(w.w)}; }
                    else { b[m][bj][0] = *(const f32x4*)(basef + off + bj * HALF); b[m][bj][1] = *(const f32x4*)(basef + off + bj * HALF + 4); } } }
            __builtin_amdgcn_sched_barrier(0);
#pragma unroll
            for (int m = 0; m < 4; ++m) {
                const int row = row0 + ai * HALF + m * 16; const size_t off = (size_t)row * D + col0; float s = 0.f;
#pragma unroll
                for (int bj = 0; bj < 2; ++bj) {
                    const f32x4 v0 = b[m][bj][0] + acc[ai][bj][m][0] * scale, v1 = b[m][bj][1] + acc[ai][bj][m][1] * scale;
                    s += ((v0[0] * v0[0] + v0[1] * v0[1]) + (v0[2] * v0[2] + v0[3] * v0[3])) + ((v1[0] * v1[0] + v1[1] * v1[1]) + (v1[2] * v1[2] + v1[3] * v1[3]));
                    if (OUT_BF) { u32x4 w; w.x = cvt_pk_bf16(v0[0], v0[1]); w.y = cvt_pk_bf16(v0[2], v0[3]); w.z = cvt_pk_bf16(v1[0], v1[1]); w.w = cvt_pk_bf16(v1[2], v1[3]); __builtin_nontemporal_store(w, (u32x4*)(outb + off + bj * HALF)); }
                    else { *(f32x4*)(outf + off + bj * HALF) = v0; *(f32x4*)(outf + off + bj * HALF + 4) = v1; }
                }
                s += __shfl_xor(s, 16); s += __shfl_xor(s, 32);
                if (fq == 0) (void)__hip_atomic_fetch_add(ssq + row, s, __ATOMIC_RELAXED, __HIP_MEMORY_SCOPE_AGENT);
            }
            asm volatile("" ::: "memory");
        }
    }
};

template <class Epi, bool ALIGN_EPI = true, bool SP2 = true>
__device__ __forceinline__ void gemm_phase(LAS unsigned char* lds, const Gemm g, const StaticOrder& S, const Epi& E) {
    int tid = threadIdx.x; asm volatile("" : "+v"(tid));
    const int wid = __builtin_amdgcn_readfirstlane(tid >> 6), lane = tid & 63, wr = wid >> 2, wc = wid & 3, fr = lane & 15, fq = lane >> 4;
    const int K = g.K, nt = K / BK;
    unsigned voffA[2], voffB[2];
#pragma unroll
    for (int i = 0; i < 2; ++i) { int R, C; stage_rc(tid * 16 + i * 8192, R, C); const int Rb = Epi::PERM ? ((R & ~31) + perm32(R & 31)) : R;
        voffA[i] = (unsigned)(R * K + C) * 2u; voffB[i] = (unsigned)(Rb * K + C) * 2u; }
    const size_t kstep = (size_t)(BK * 2);
    const size_t hstep = (size_t)HALF * K * 2;
    const size_t tstep = 2 * hstep;
    const unsigned ldsw = (unsigned)wid * 1024u;
    const int aoff = lds_byte(wr * 64 + fr, fq * 8), boff = lds_byte(wc * 32 + fr, fq * 8);
#define PG8_SA(b, h) (((b) * 2 + (h)) * HTB)
#define PG8_SB(b, h) ((4 + (b) * 2 + (h)) * HTB)
#define PG8_STAGE(bufoff, gbase, voff) do { _Pragma("unroll") for (int _i = 0; _i < 2; ++_i) \
        __builtin_amdgcn_global_load_lds((const unsigned*)((const char*)(gbase) + (voff)[_i]), (LAS unsigned*)(lds + (bufoff) + ldsw + _i * 8192), 16, 0, 0); } while (0)
#define PG8_LDA(dst, b, h) do { _Pragma("unroll") for (int m = 0; m < 4; ++m) _Pragma("unroll") for (int k = 0; k < 2; ++k) dst[m][k] = *(const LAS bf16x8*)(lds + PG8_SA(b, h) + aoff + m * 2048 + k * 1024); } while (0)
#define PG8_LDB(dst, b, h) do { _Pragma("unroll") for (int n = 0; n < 2; ++n) _Pragma("unroll") for (int k = 0; k < 2; ++k) dst[n][k] = *(const LAS bf16x8*)(lds + PG8_SB(b, h) + boff + n * 2048 + k * 1024); } while (0)
#define PG8_MMA(ai, bj, At, Bt) do { __builtin_amdgcn_s_setprio(1); _Pragma("unroll") for (int m = 0; m < 4; ++m) _Pragma("unroll") for (int n = 0; n < 2; ++n) _Pragma("unroll") for (int k = 0; k < 2; ++k) \
        acc[ai][bj][m][n] = __builtin_amdgcn_mfma_f32_16x16x32_bf16(Bt[n][k], At[m][k], acc[ai][bj][m][n], 0, 0, 0); __builtin_amdgcn_s_setprio(0); } while (0)
#define PG8_WAIT_V(n) asm volatile("s_waitcnt vmcnt(" #n ")" ::: "memory")
#define PG8_WAIT_L(n) asm volatile("s_waitcnt lgkmcnt(" #n ")" ::: "memory")
#define PG8_BAR __builtin_amdgcn_s_barrier()
#define PG8_SCHED __builtin_amdgcn_sched_barrier(0)
    Unit cur, nxt; int ui = 0;
    if (!S.next(0, cur)) return;
    f32x4 acc[2][2][4][2];
#pragma unroll
    for (int a = 0; a < 2; ++a)
#pragma unroll
        for (int b = 0; b < 2; ++b)
#pragma unroll
            for (int m = 0; m < 4; ++m)
#pragma unroll
                for (int n = 0; n < 2; ++n) acc[a][b][m][n] = (f32x4){0.f, 0.f, 0.f, 0.f};
    bf16x8 At[4][2], B0[2][2], B1[2][2];
    const char* cA = (const char*)g.A + (size_t)cur.pm * tstep; const char* cB = (const char*)g.Bt + (size_t)cur.pn * tstep;
    if constexpr (SP2) {
        PG8_STAGE(PG8_SB(0, 0), cB, voffB); PG8_STAGE(PG8_SB(0, 1), cB + hstep, voffB); PG8_STAGE(PG8_SA(0, 0), cA, voffA); PG8_STAGE(PG8_SA(0, 1), cA + hstep, voffA);
        if (wr == 1) PG8_BAR;
        PG8_WAIT_V(2); PG8_BAR;
        PG8_STAGE(PG8_SB(1, 0), cB + kstep, voffB); PG8_STAGE(PG8_SA(1, 0), cA + kstep, voffA); PG8_STAGE(PG8_SB(1, 1), cB + hstep + kstep, voffB);
        PG8_WAIT_V(6); PG8_BAR;
    } else {
        PG8_STAGE(PG8_SB(0, 0), cB, voffB); PG8_STAGE(PG8_SA(0, 0), cA, voffA); PG8_STAGE(PG8_SB(0, 1), cB + hstep, voffB); PG8_STAGE(PG8_SA(0, 1), cA + hstep, voffA);
        if (wr == 1) PG8_BAR;
        PG8_WAIT_V(4); PG8_BAR;
        PG8_STAGE(PG8_SB(1, 0), cB + kstep, voffB); PG8_STAGE(PG8_SA(1, 0), cA + kstep, voffA); PG8_STAGE(PG8_SB(1, 1), cB + hstep + kstep, voffB);
        PG8_WAIT_V(6); PG8_BAR;
    }
    for (;;) {
        const bool has_next = S.next(ui + 1, nxt);
        const char* nA = has_next ? (const char*)g.A + (size_t)nxt.pm * tstep : cA; const char* nB = has_next ? (const char*)g.Bt + (size_t)nxt.pn * tstep : cB;
        for (int t = 0; t < nt; t += 2) {
            const bool last = (t == nt - 2);
            const char* a1 = cA + (size_t)(t + 1) * kstep;
            const char* a2 = last ? nA : cA + (size_t)(t + 2) * kstep; const char* b2 = last ? nB : cB + (size_t)(t + 2) * kstep;
            const char* a3 = a2 + kstep; const char* b3 = b2 + kstep;
            if constexpr (SP2) {
            PG8_LDB(B0, 0, 0); PG8_LDB(B1, 0, 1); PG8_SCHED; PG8_LDA(At, 0, 0); PG8_STAGE(PG8_SA(1, 1), a1 + hstep, voffA);
            PG8_WAIT_V(8); PG8_WAIT_L(0); PG8_BAR; PG8_MMA(0, 0, At, B0); PG8_MMA(0, 1, At, B1); PG8_BAR; PG8_SCHED;
            PG8_LDA(At, 0, 1); PG8_STAGE(PG8_SB(0, 0), b2, voffB); PG8_STAGE(PG8_SB(0, 1), b2 + hstep, voffB); PG8_STAGE(PG8_SA(0, 0), a2, voffA);
            PG8_WAIT_V(8); PG8_WAIT_L(0); PG8_BAR; PG8_MMA(1, 0, At, B0); PG8_MMA(1, 1, At, B1); PG8_BAR; PG8_SCHED;
            PG8_LDB(B0, 1, 0); PG8_LDB(B1, 1, 1); PG8_SCHED; PG8_LDA(At, 1, 0); PG8_STAGE(PG8_SA(0, 1), a2 + hstep, voffA);
            PG8_WAIT_V(8); PG8_WAIT_L(0); PG8_BAR; PG8_MMA(0, 0, At, B0); PG8_MMA(0, 1, At, B1); PG8_BAR; PG8_SCHED;
            PG8_LDA(At, 1, 1); PG8_STAGE(PG8_SB(1, 0), b3, voffB); PG8_STAGE(PG8_SB(1, 1), b3 + hstep, voffB); PG8_STAGE(PG8_SA(1, 0), a3, voffA);
            PG8_WAIT_V(8); PG8_WAIT_L(0); PG8_BAR; PG8_MMA(1, 0, At, B0); PG8_MMA(1, 1, At, B1); PG8_BAR; PG8_SCHED;
            } else {
            PG8_LDB(B0, 0, 0); PG8_SCHED; PG8_LDA(At, 0, 0); PG8_STAGE(PG8_SA(1, 1), a1 + hstep, voffA);
            PG8_WAIT_L(8); PG8_BAR; PG8_WAIT_L(0); PG8_MMA(0, 0, At, B0); PG8_BAR; PG8_SCHED;
            PG8_LDB(B1, 0, 1); PG8_STAGE(PG8_SB(0, 0), b2, voffB);
            PG8_BAR; PG8_WAIT_L(0); PG8_MMA(0, 1, At, B1); PG8_BAR;
            PG8_LDA(At, 0, 1); PG8_STAGE(PG8_SA(0, 0), a2, voffA);
            PG8_BAR; PG8_WAIT_L(0); PG8_MMA(1, 0, At, B0); PG8_BAR; PG8_SCHED;
            PG8_STAGE(PG8_SB(0, 1), b2 + hstep, voffB);
            PG8_WAIT_V(6); PG8_BAR; PG8_MMA(1, 1, At, B1); PG8_BAR;
            PG8_LDB(B0, 1, 0); PG8_SCHED; PG8_LDA(At, 1, 0); PG8_STAGE(PG8_SA(0, 1), a2 + hstep, voffA);
            PG8_WAIT_L(8); PG8_BAR; PG8_WAIT_L(0); PG8_MMA(0, 0, At, B0); PG8_BAR; PG8_SCHED;
            PG8_LDB(B1, 1, 1); PG8_STAGE(PG8_SB(1, 0), b3, voffB);
            PG8_BAR; PG8_WAIT_L(0); PG8_MMA(0, 1, At, B1); PG8_BAR;
            PG8_LDA(At, 1, 1); PG8_STAGE(PG8_SA(1, 0), a3, voffA);
            PG8_BAR; PG8_WAIT_L(0); PG8_MMA(1, 0, At, B0); PG8_BAR; PG8_SCHED;
            PG8_STAGE(PG8_SB(1, 1), b3 + hstep, voffB);
            PG8_WAIT_V(6); PG8_BAR; PG8_MMA(1, 1, At, B1); PG8_BAR;
            }
        }
        if constexpr (ALIGN_EPI) { if (wr == 0) PG8_BAR; }
        E(acc, cur, wr, wc, fr, fq);
        if (!has_next) break;
#pragma unroll
        for (int a = 0; a < 2; ++a)
#pragma unroll
            for (int b = 0; b < 2; ++b)
#pragma unroll
                for (int m = 0; m < 4; ++m)
#pragma unroll
                    for (int n = 0; n < 2; ++n) acc[a][b][m][n] = (f32x4){0.f, 0.f, 0.f, 0.f};
        cur = nxt; cA = nA; cB = nB; ++ui;
        if constexpr (ALIGN_EPI) { if (wr == 1) PG8_BAR; }
    }
    PG8_WAIT_V(0);
    if constexpr (!ALIGN_EPI) { if (wr == 0) PG8_BAR; }
    PG8_BAR;
#undef PG8_SA
#undef PG8_SB
#undef PG8_STAGE
#undef PG8_LDA
#undef PG8_LDB
#undef PG8_MMA
#undef PG8_WAIT_V
#undef PG8_WAIT_L
#undef PG8_BAR
#undef PG8_SCHED
}
}

#define LDS_WAIT() asm volatile("s_waitcnt lgkmcnt(0)" ::: "memory")
__device__ __forceinline__ float wave_sum(float v) {
#pragma unroll
    for (int o = 1; o < 64; o <<= 1) v += __shfl_xor(v, o);
    return v;
}
struct P0Desc { const float* W; bf16_t* WT; const float* ks; int K, N, mode, item; };
__device__ __forceinline__ void p0_load(const P0Desc& d, f32x4 (&v)[8], float (&sc)[8], int lane) {
    const int nblk = d.N / 32, kb = d.item / nblk, nb = d.item % nblk, k0 = 64 * kb, n0 = 32 * nb, kr = lane >> 3, nc = (lane & 7) * 4;
#pragma unroll
    for (int i = 0; i < 8; ++i) { v[i] = __builtin_nontemporal_load((const f32x4*)(d.W + (size_t)(k0 + kr + 8 * i) * d.N + n0 + nc)); sc[i] = d.ks ? d.ks[k0 + kr + 8 * i] : 1.0f; }
}
__device__ __forceinline__ void p0_finish(const P0Desc& d, const f32x4 (&v)[8], const float (&sc)[8], LAS float* scr, int lane) {
    const int nblk = d.N / 32, kb = d.item / nblk, nb = d.item % nblk, k0 = 64 * kb, n0 = 32 * nb, kr = lane >> 3, nc = (lane & 7) * 4;
#pragma unroll
    for (int i = 0; i < 8; ++i) { LAS float* p = scr + (kr + 8 * i) * 33 + nc; p[0] = v[i][0] * sc[i]; p[1] = v[i][1] * sc[i]; p[2] = v[i][2] * sc[i]; p[3] = v[i][3] * sc[i]; }
    LDS_WAIT(); asm volatile("" ::: "memory");
    const int c = lane & 7;
    int rb;
    if (d.mode == 0) rb = n0;
    else if (d.mode == 3) rb = (n0 < 5 * HW) ? n0 : ((n0 < 6 * HW) ? 5 * HW + (((n0 - 5 * HW) >> 7) * 256) + ((n0 - 5 * HW) & 127) : 5 * HW + (((n0 - 6 * HW) >> 7) * 256) + 128 + ((n0 - 6 * HW) & 127));
    else rb = (n0 >> 7) * 256 + (d.mode == 2 ? 128 : 0) + (n0 & 127);
#pragma unroll
    for (int j = 0; j < 4; ++j) { const int n = (lane >> 3) + 8 * j; const LAS float* sp = scr + (8 * c) * 33 + n;
        u32x4 o; o.x = pk2(sp[0 * 33], sp[1 * 33]); o.y = pk2(sp[2 * 33], sp[3 * 33]); o.z = pk2(sp[4 * 33], sp[5 * 33]); o.w = pk2(sp[6 * 33], sp[7 * 33]);
        *(u32x4*)(d.WT + (size_t)(rb + n) * d.K + k0 + 8 * c) = o; }
    LDS_WAIT(); asm volatile("" ::: "memory");
}


#define XB_TMO      128
#define XB_XCNT(j)  (256  + 64 * (j))
#define XB_XSUB(j)  (1280 + 64 * (j))
#define XB_XGEN(j)  (2304 + 64 * (j))
#define XB_TOP      3328
#define XB_TOPGEN   3392
#define XCD_BAR_WORDS 3456
#define XB_SPIN_CAP (1u << 18)
__device__ __forceinline__ unsigned xb_ld(unsigned* p)              { return __hip_atomic_load(p, __ATOMIC_RELAXED, __HIP_MEMORY_SCOPE_AGENT); }
__device__ __forceinline__ unsigned xb_add(unsigned* p, unsigned v) { return __hip_atomic_fetch_add(p, v, __ATOMIC_RELAXED, __HIP_MEMORY_SCOPE_AGENT); }
__device__ __forceinline__ unsigned xb_xcc_id() { return (unsigned)__builtin_amdgcn_s_getreg((3 << 11) | 20) & 0xFu; }
#define XB_SPIN(cond, bar) do { unsigned _sp = 0; while (cond) { __builtin_amdgcn_s_sleep(1); \
    if ((++_sp & 255u) == 0u) { if (xb_ld(&(bar)[XB_TMO])) break; if (_sp > XB_SPIN_CAP) { atomicAdd(&(bar)[XB_TMO], 1u); break; } } } } while (0)
struct XcdBarrier { unsigned* bar; unsigned x; volatile LAS unsigned* st; };
__device__ __forceinline__ XcdBarrier xcd_barrier_post(unsigned* bar, volatile LAS unsigned* st) {
    XcdBarrier b; b.bar = bar; b.x = xb_xcc_id(); b.st = st;
    if (threadIdx.x == 0) (void)xb_add(&bar[XB_XCNT(b.x)], 1u);
    return b;
}
__device__ __forceinline__ void xcd_barrier_complete(unsigned* bar, unsigned x, unsigned& nloc, unsigned& nx) {
    const unsigned G = gridDim.x * gridDim.y * gridDim.z;
    unsigned sum, cnt, mine, sp = 0u;
    for (;;) {
        sum = 0u; cnt = 0u; mine = 0u;
#pragma unroll
        for (unsigned j = 0; j < 16; ++j) { const unsigned c = xb_ld(&bar[XB_XCNT(j)]); sum += c; cnt += (c > 0u) ? 1u : 0u; mine = (j == x) ? c : mine; }
        if (sum == G) break;
        __builtin_amdgcn_s_sleep(1);
        if ((++sp & 255u) == 0u) { if (xb_ld(&bar[XB_TMO])) break; if (sp > XB_SPIN_CAP) { atomicAdd(&bar[XB_TMO], 1u); break; } }
    }
    nloc = mine > 0u ? mine : 1u; nx = cnt > 0u ? cnt : 1u;
}
__device__ __forceinline__ void xcd_barrier(const XcdBarrier& b) {
    asm volatile("s_waitcnt vmcnt(0)" ::: "memory");
    __syncthreads();
    if (threadIdx.x == 0) {
        unsigned* bar = b.bar;
        __builtin_amdgcn_s_waitcnt(0);
        unsigned nloc = b.st[0], nx = b.st[1];
        if (nloc == 0u) { xcd_barrier_complete(bar, b.x, nloc, nx); b.st[0] = nloc; b.st[1] = nx; }
        const unsigned old = xb_add(&bar[XB_XSUB(b.x)], 1u);
        const unsigned gen = old / nloc;
        if (old + 1u == (gen + 1u) * nloc) {
            __builtin_amdgcn_fence(__ATOMIC_RELEASE, "agent");
            asm volatile("s_waitcnt vmcnt(0)" ::: "memory");
            const unsigned og = xb_add(&bar[XB_TOP], 1u);
            const unsigned tg = og / nx;
            if (og + 1u == (tg + 1u) * nx) xb_add(&bar[XB_TOPGEN], 1u);
            else XB_SPIN(xb_ld(&bar[XB_TOPGEN]) == tg, bar);
            __builtin_amdgcn_fence(__ATOMIC_ACQUIRE, "agent");
            xb_add(&bar[XB_XGEN(b.x)], 1u);
            asm volatile("s_waitcnt vmcnt(0)" ::: "memory");
        } else {
            XB_SPIN(xb_ld(&bar[XB_XGEN(b.x)]) == gen, bar);
            __builtin_amdgcn_fence(__ATOMIC_ACQUIRE, "agent");
            asm volatile("s_waitcnt vmcnt(0)" ::: "memory");
        }
    }
    __syncthreads();
}


__device__ __forceinline__ void hgrn_p1(LAS unsigned char* lds, bf16_t* PROJ, const float* lbl, bf16_t* OLOC, float* TG, float* CUMG, float* DSEG, int item, int tid_in) {
    int tid = tid_in; asm volatile("" : "+v"(tid));
    constexpr int QS = 272, TS = 144;
    LAS unsigned char* Qd = lds;
    LAS unsigned char* Kd = lds + 17408;
    LAS unsigned char* KsT = lds + 34816;
    LAS unsigned char* VT = KsT + 18432;
    LAS unsigned char* ST = VT + 18432;
    LAS unsigned char* Pm = ST + 34816;
    LAS unsigned char* GT = Pm + 9216;
    LAS unsigned char* DEC = GT + 4096;
    const int lane = tid & 63, w = __builtin_amdgcn_readfirstlane(tid >> 6), r = lane & 15, q = lane >> 4;
    const int b = item >> 5, h = (item >> 2) & 7, g = item & 3;
    const size_t row0 = (size_t)b * SEQ + (size_t)g * 512;
    const int kp = lane, tg = w;
    const int ci = w & 3, vh = w >> 2;
    const float lb0 = sigmoidf_(lbl[h * HD + 2 * kp] - lbl[HW + h * HD + 2 * kp]), lb1 = sigmoidf_(lbl[h * HD + 2 * kp + 1] - lbl[HW + h * HD + 2 * kp + 1]);
    __syncthreads();
    for (int i = tid; i < 34816 / 16; i += 512) *(LAS u32x4*)(ST + i * 16) = (u32x4){0u, 0u, 0u, 0u};
    f32x4 accS[8];
#pragma unroll
    for (int i = 0; i < 8; ++i) accS[i] = (f32x4){0.f, 0.f, 0.f, 0.f};
    char* sbase = (char*)(PROJ + (row0 + 8 * tg) * INC + h * HD);
    const unsigned voff = 4u * (unsigned)kp;
    float cum0 = 1.f, cum1 = 1.f;
    float* cumg = CUMG + ((size_t)(b * 8 + h) * 32 + g * 8) * 128 + 2 * kp;
    unsigned rq[8], rf[8], rv[8];
#pragma unroll
    for (int i = 0; i < 8; ++i) { const char* p = sbase + (size_t)i * INC * 2; rq[i] = *(const unsigned*)(p + voff); rf[i] = *(const unsigned*)(p + HW * 2 + voff); rv[i] = *(const unsigned*)(p + 4 * HW + voff); }
    for (int n = 0; n < 8; ++n) {
        f32x2 fv[8], cpv[8]; f32x2 cc = {1.f, 1.f};
        const f32x2 lbv = {lb0, lb1}, omlb = {1.f - lb0, 1.f - lb1};
#pragma unroll
        for (int i = 0; i < 8; ++i) {
            const f32x2 xv = {bf_lo(rf[i]), bf_hi(rf[i])}; const f32x2 tv = xv * (-1.4426950408889634f);
            f32x2 ev; ev.x = __builtin_amdgcn_exp2f(tv.x); ev.y = __builtin_amdgcn_exp2f(tv.y);
            const f32x2 dv = ev + 1.0f; f32x2 sv; sv.x = __builtin_amdgcn_rcpf(dv.x); sv.y = __builtin_amdgcn_rcpf(dv.y);
            fv[i] = lbv + omlb * sv; cc = cc * fv[i]; cpv[i] = cc;
        }
        *(LAS f32x2*)(GT + (tg * 128 + 2 * kp) * 4) = cc;
        __syncthreads();
        f32x2 prev = {1.f, 1.f}, totv = {1.f, 1.f};
#pragma unroll
        for (int gg = 0; gg < 8; ++gg) { const f32x2 gv = *(const LAS f32x2*)(GT + (gg * 128 + 2 * kp) * 4); if (gg < tg) prev = prev * gv; totv = totv * gv; }
        {
            f32x2 rP[8];
            {   const f32x2 p7 = prev * cpv[7]; rP[7].x = __builtin_amdgcn_rcpf(fmaxf(p7.x, 1e-30f)); rP[7].y = __builtin_amdgcn_rcpf(fmaxf(p7.y, 1e-30f)); }
#pragma unroll
            for (int i = 6; i >= 0; --i) rP[i] = rP[i + 1] * fv[i + 1];
            f32x2 ksv[8];
#pragma unroll
            for (int i = 0; i < 8; ++i) {
                const f32x2 Pv = prev * cpv[i];
                const f32x2 kd = (1.0f - fv[i]) * rP[i];
                const f32x2 qv = {bf_lo(rq[i]), bf_hi(rq[i])}; const f32x2 qdv = qv * Pv;
                const int t = 8 * tg + i;
                const unsigned qd = pg8::cvt_pk_bf16(qdv.x, qdv.y);
                *(LAS unsigned*)(Qd + t * QS + 4 * kp) = qd;
                *(unsigned*)(sbase + (size_t)(n * 64 + i) * INC * 2 + voff) = qd;
                *(LAS unsigned*)(Kd + t * QS + 4 * kp) = pg8::cvt_pk_bf16(kd.x, kd.y);
                ksv[i] = kd * totv;
            }
            u32x4 a0, a1, v0, v1;
            a0.x = pg8::cvt_pk_bf16(ksv[0].x, ksv[1].x); a0.y = pg8::cvt_pk_bf16(ksv[2].x, ksv[3].x); a0.z = pg8::cvt_pk_bf16(ksv[4].x, ksv[5].x); a0.w = pg8::cvt_pk_bf16(ksv[6].x, ksv[7].x);
            a1.x = pg8::cvt_pk_bf16(ksv[0].y, ksv[1].y); a1.y = pg8::cvt_pk_bf16(ksv[2].y, ksv[3].y); a1.z = pg8::cvt_pk_bf16(ksv[4].y, ksv[5].y); a1.w = pg8::cvt_pk_bf16(ksv[6].y, ksv[7].y);
            v0.x = (rv[0] & 0xffffu) | (rv[1] << 16); v0.y = (rv[2] & 0xffffu) | (rv[3] << 16); v0.z = (rv[4] & 0xffffu) | (rv[5] << 16); v0.w = (rv[6] & 0xffffu) | (rv[7] << 16);
            v1.x = (rv[0] >> 16) | (rv[1] & 0xffff0000u); v1.y = (rv[2] >> 16) | (rv[3] & 0xffff0000u); v1.z = (rv[4] >> 16) | (rv[5] & 0xffff0000u); v1.w = (rv[6] >> 16) | (rv[7] & 0xffff0000u);
            *(LAS u32x4*)(KsT + (2 * kp) * TS + 16 * tg) = a0; *(LAS u32x4*)(KsT + (2 * kp + 1) * TS + 16 * tg) = a1;
            *(LAS u32x4*)(VT + (2 * kp) * TS + 16 * tg) = v0; *(LAS u32x4*)(VT + (2 * kp + 1) * TS + 16 * tg) = v1;
            if (tg == 0) { *(LAS f32x2*)(DEC + 8 * kp) = totv; *(f32x2*)(cumg + n * 128) = (f32x2){cum0, cum1}; }
            cum0 *= totv.x; cum1 *= totv.y;
        }
        __syncthreads();
        if (n + 1 < 8) {
#pragma unroll
            for (int i = 0; i < 8; ++i) { const char* p = sbase + (size_t)((n + 1) * 64 + i) * INC * 2; rq[i] = *(const unsigned*)(p + voff); rf[i] = *(const unsigned*)(p + HW * 2 + voff); rv[i] = *(const unsigned*)(p + 4 * HW + voff); }
        }
        {
            const int si = w & 3, c20 = 2 * (w >> 2);
            bf16x8 av[4], b0[4], b1[4];
            if (si <= c20 + 1) {
#pragma unroll
                for (int kk = 0; kk < 4; ++kk) { av[kk] = *(const LAS bf16x8*)(Kd + (16 * si + r) * QS + (32 * kk + 8 * q) * 2);
                    b0[kk] = *(const LAS bf16x8*)(Qd + (16 * c20 + r) * QS + (32 * kk + 8 * q) * 2); b1[kk] = *(const LAS bf16x8*)(Qd + (16 * (c20 + 1) + r) * QS + (32 * kk + 8 * q) * 2); }
            }
            __builtin_amdgcn_sched_barrier(0);
            f32x4 acc0 = (f32x4){0.f, 0.f, 0.f, 0.f}, acc1 = (f32x4){0.f, 0.f, 0.f, 0.f};
            if (si <= c20 + 1) {
#pragma unroll
                for (int kk = 0; kk < 4; ++kk) { acc0 = __builtin_amdgcn_mfma_f32_16x16x32_bf16(av[kk], b0[kk], acc0, 0, 0, 0); acc1 = __builtin_amdgcn_mfma_f32_16x16x32_bf16(av[kk], b1[kk], acc1, 0, 0, 0); }
            }
#pragma unroll
            for (int j = 0; j < 4; ++j) { if (si > c20 || (si == c20 && 4 * q + j > r)) acc0[j] = 0.f; if (si == c20 + 1 && 4 * q + j > r) acc1[j] = 0.f; }
            u32x2 pw; pw.x = pg8::cvt_pk_bf16(acc0[0], acc0[1]); pw.y = pg8::cvt_pk_bf16(acc0[2], acc0[3]);
            *(LAS u32x2*)(Pm + (16 * c20 + r) * TS + (16 * si + 4 * q) * 2) = pw;
            pw.x = pg8::cvt_pk_bf16(acc1[0], acc1[1]); pw.y = pg8::cvt_pk_bf16(acc1[2], acc1[3]);
            *(LAS u32x2*)(Pm + (16 * (c20 + 1) + r) * TS + (16 * si + 4 * q) * 2) = pw;
        }
        __syncthreads();
        {
            bf16x8 pa[2], qa[4], bb[6];
#pragma unroll
            for (int kk = 0; kk < 2; ++kk) pa[kk] = *(const LAS bf16x8*)(Pm + (16 * ci + r) * TS + (32 * kk + 8 * q) * 2);
#pragma unroll
            for (int kk = 0; kk < 4; ++kk) qa[kk] = *(const LAS bf16x8*)(Qd + (16 * ci + r) * QS + (32 * kk + 8 * q) * 2);
            bf16_t* op = OLOC + (row0 + (size_t)n * 64 + 16 * ci + r) * HW + h * HD + 64 * vh + 4 * q;
#pragma unroll
            for (int i = 0; i < 4; ++i) {
                const int vt = 4 * vh + i;
#pragma unroll
                for (int kk = 0; kk < 2; ++kk) bb[kk] = *(const LAS bf16x8*)(VT + (16 * vt + r) * TS + (32 * kk + 8 * q) * 2);
#pragma unroll
                for (int kk = 0; kk < 4; ++kk) bb[2 + kk] = *(const LAS bf16x8*)(ST + (16 * vt + r) * QS + (32 * kk + 8 * q) * 2);
                __builtin_amdgcn_sched_barrier(0);
                f32x4 acc = (f32x4){0.f, 0.f, 0.f, 0.f};
#pragma unroll
                for (int kk = 0; kk < 2; ++kk) acc = __builtin_amdgcn_mfma_f32_16x16x32_bf16(bb[kk], pa[kk], acc, 0, 0, 0);
#pragma unroll
                for (int kk = 0; kk < 4; ++kk) acc = __builtin_amdgcn_mfma_f32_16x16x32_bf16(bb[2 + kk], qa[kk], acc, 0, 0, 0);
                { u32x2 ow; ow.x = pg8::cvt_pk_bf16(acc[0], acc[1]); ow.y = pg8::cvt_pk_bf16(acc[2], acc[3]); *(u32x2*)(op + 16 * i) = ow; }
                __builtin_amdgcn_sched_barrier(0);
            }
        }
        __syncthreads();
        {
            const f32x4 dkc = *(const LAS f32x4*)(DEC + (16 * w + 4 * q) * 4);
            bf16x8 ka[2], vb[8];
#pragma unroll
            for (int kk = 0; kk < 2; ++kk) ka[kk] = *(const LAS bf16x8*)(KsT + (16 * w + r) * TS + (32 * kk + 8 * q) * 2);
#pragma unroll
            for (int hf = 0; hf < 2; ++hf) {
#pragma unroll
                for (int t4 = 0; t4 < 4; ++t4)
#pragma unroll
                    for (int kk = 0; kk < 2; ++kk) vb[2 * t4 + kk] = *(const LAS bf16x8*)(VT + (16 * (4 * hf + t4) + r) * TS + (32 * kk + 8 * q) * 2);
                __builtin_amdgcn_sched_barrier(0);
#pragma unroll
                for (int t4 = 0; t4 < 4; ++t4) {
                    const int ni = 4 * hf + t4;
                    f32x4 acc = accS[ni] * dkc;
#pragma unroll
                    for (int kk = 0; kk < 2; ++kk) acc = __builtin_amdgcn_mfma_f32_16x16x32_bf16(ka[kk], vb[2 * t4 + kk], acc, 0, 0, 0);
                    accS[ni] = acc;
                }
                __builtin_amdgcn_sched_barrier(0);
            }
#pragma unroll
            for (int ni = 0; ni < 8; ++ni) { u32x2 sw; sw.x = pg8::cvt_pk_bf16(accS[ni][0], accS[ni][1]); sw.y = pg8::cvt_pk_bf16(accS[ni][2], accS[ni][3]);
                *(LAS u32x2*)(ST + (16 * ni + r) * QS + (16 * w + 4 * q) * 2) = sw; }
        }
    }
    {   f32x4* tg4 = (f32x4*)TG + ((size_t)item * 8 + w) * 8 * 64 + lane;
#pragma unroll
        for (int ni = 0; ni < 8; ++ni) tg4[ni * 64] = accS[ni];
        if (tg == 0) *(f32x2*)(DSEG + (size_t)item * 128 + 2 * kp) = (f32x2){cum0, cum1};
    }
    __syncthreads();
}

__device__ __forceinline__ void hgrn_p2(LAS unsigned char* lds, const bf16_t* PROJ, const bf16_t* OLOC, const float* TG, const float* CUMG, const float* DSEG, const float* nw, bf16_t* MIX, int item, int tid_in) {
    int tid = tid_in; asm volatile("" : "+v"(tid));
    constexpr int QS = 272;
    LAS unsigned char* Qd = lds;
    LAS unsigned char* ST = lds + 17408;
    LAS unsigned char* NRM = ST + 34816;
    LAS unsigned char* OT = NRM + 2048;
    const int lane = tid & 63, w = __builtin_amdgcn_readfirstlane(tid >> 6), r = lane & 15, q = lane >> 4;
    const int b = item >> 5, h = (item >> 2) & 7, g = item & 3;
    const size_t row0 = (size_t)b * SEQ + (size_t)g * 512;
    const int ci = w & 3, vh = w >> 2;
    f32x4 sin[8];
#pragma unroll
    for (int i = 0; i < 8; ++i) sin[i] = (f32x4){0.f, 0.f, 0.f, 0.f};
    for (int gp = 0; gp < g; ++gp) {
        const int it2 = item - g + gp;
        const f32x4 ds = *(const f32x4*)(DSEG + (size_t)it2 * 128 + 16 * w + 4 * q);
        const f32x4* tg4 = (const f32x4*)TG + ((size_t)it2 * 8 + w) * 8 * 64 + lane;
#pragma unroll
        for (int ni = 0; ni < 8; ++ni) sin[ni] = sin[ni] * ds + tg4[ni * 64];
    }
    const float* cumg = CUMG + ((size_t)(b * 8 + h) * 32 + g * 8) * 128 + 16 * w + 4 * q;
    const char* qbase = (const char*)(PROJ + row0 * INC + h * HD);
    const unsigned qoff = (unsigned)(tid >> 4) * (INC * 2) + (unsigned)(tid & 15) * 16u;
    const char* gbase = (const char*)(PROJ + (row0 + 16 * ci) * INC + 3 * HW + h * HD + 64 * vh);
    const unsigned go = (unsigned)r * (INC * 2) + 8u * (unsigned)q;
    const float* nwp = nw + h * HD + 64 * vh + 4 * q;
    f32x4 nv[4];
#pragma unroll
    for (int i = 0; i < 4; ++i) nv[i] = *(const f32x4*)(nwp + 16 * i);
    u32x4 lq[2]; u32x2 lo[4], gt[4]; f32x4 cmn;
#define HP2_LOAD(nn) do { \
        if (g > 0) { _Pragma("unroll") for (int j = 0; j < 2; ++j) lq[j] = *(const u32x4*)(qbase + (size_t)((nn) * 64 + 32 * j) * INC * 2 + qoff); cmn = *(const f32x4*)(cumg + (nn) * 128); } \
        const bf16_t* op_ = OLOC + (row0 + (size_t)(nn) * 64 + 16 * ci + r) * HW + h * HD + 64 * vh + 4 * q; \
        _Pragma("unroll") for (int i = 0; i < 4; ++i) { lo[i] = *(const u32x2*)(op_ + 16 * i); gt[i] = *(const u32x2*)(gbase + (size_t)(nn) * 64 * INC * 2 + (size_t)(32 * i) + go); } \
    } while (0)
    HP2_LOAD(0);
    __syncthreads();
    for (int n = 0; n < 8; ++n) {
        f32x4 o[4]; u32x2 gc[4];
#pragma unroll
        for (int i = 0; i < 4; ++i) { o[i] = (f32x4){bf_lo(lo[i].x), bf_hi(lo[i].x), bf_lo(lo[i].y), bf_hi(lo[i].y)}; gc[i] = gt[i]; }
        if (g > 0) {
            const f32x4 cm = cmn;
#pragma unroll
            for (int ni = 0; ni < 8; ++ni) { const f32x4 sv = sin[ni] * cm; u32x2 sw; sw.x = pg8::cvt_pk_bf16(sv[0], sv[1]); sw.y = pg8::cvt_pk_bf16(sv[2], sv[3]);
                *(LAS u32x2*)(ST + (16 * ni + r) * QS + (16 * w + 4 * q) * 2) = sw; }
#pragma unroll
            for (int j = 0; j < 2; ++j) { const int t = (tid >> 4) + 32 * j, c = tid & 15; *(LAS u32x4*)(Qd + t * QS + c * 16) = lq[j]; }
        }
        __syncthreads();
        if (n + 1 < 8) HP2_LOAD(n + 1);
        if (g > 0) {
            bf16x8 qa[4], bb[4];
#pragma unroll
            for (int kk = 0; kk < 4; ++kk) qa[kk] = *(const LAS bf16x8*)(Qd + (16 * ci + r) * QS + (32 * kk + 8 * q) * 2);
#pragma unroll
            for (int i = 0; i < 4; ++i) {
#pragma unroll
                for (int kk = 0; kk < 4; ++kk) bb[kk] = *(const LAS bf16x8*)(ST + (16 * (4 * vh + i) + r) * QS + (32 * kk + 8 * q) * 2);
                __builtin_amdgcn_sched_barrier(0);
                f32x4 acc = o[i];
#pragma unroll
                for (int kk = 0; kk < 4; ++kk) acc = __builtin_amdgcn_mfma_f32_16x16x32_bf16(bb[kk], qa[kk], acc, 0, 0, 0);
                o[i] = acc;
                __builtin_amdgcn_sched_barrier(0);
            }
        }
        {
            float sq = 0.f;
#pragma unroll
            for (int i = 0; i < 4; ++i) sq += (o[i][0] * o[i][0] + o[i][1] * o[i][1]) + (o[i][2] * o[i][2] + o[i][3] * o[i][3]);
            *(LAS float*)(NRM + ((vh * 4 + q) * 64 + 16 * ci + r) * 4) = sq;
        }
        __syncthreads();
        {
            float ssum = 0.f;
#pragma unroll
            for (int gg = 0; gg < 8; ++gg) ssum += *(const LAS float*)(NRM + (gg * 64 + 16 * ci + r) * 4);
            const float rs = __builtin_amdgcn_rsqf(ssum * (1.0f / HD) + EPS);
            LAS unsigned char* ot = OT + w * 2304;
#pragma unroll
            for (int i = 0; i < 4; ++i) {
                const float g0 = bf_lo(gc[i].x), g1 = bf_hi(gc[i].x), g2 = bf_lo(gc[i].y), g3 = bf_hi(gc[i].y);
                u32x2 ow; ow.x = pg8::cvt_pk_bf16(o[i][0] * rs * nv[i][0] * siluf_(g0), o[i][1] * rs * nv[i][1] * siluf_(g1));
                ow.y = pg8::cvt_pk_bf16(o[i][2] * rs * nv[i][2] * siluf_(g2), o[i][3] * rs * nv[i][3] * siluf_(g3));
                *(LAS u32x2*)(ot + r * 144 + (16 * i + 4 * q) * 2) = ow;
            }
            asm volatile("s_waitcnt lgkmcnt(0)" ::: "memory");
#pragma unroll
            for (int j = 0; j < 2; ++j) { const int rr = (lane >> 3) + 8 * j, pc = lane & 7;
                const u32x4 ov = *(const LAS u32x4*)(ot + rr * 144 + pc * 16);
                *(u32x4*)(MIX + (row0 + (size_t)n * 64 + 16 * ci + rr) * D + h * HD + 64 * vh + pc * 8) = ov; }
        }
        __syncthreads();
    }
#undef HP2_LOAD
}

struct Args { const float* in[16]; float* out; unsigned char* ws; int use_cg; int pad; };

__global__ void __launch_bounds__(512, 2) mk_fwd(Args a) {
    extern __shared__ __attribute__((aligned(16))) unsigned char lds_raw[];
    LAS unsigned char* lds = (LAS unsigned char*)lds_raw;
    cg::grid_group grid = cg::this_grid();
    const int tid = threadIdx.x, lane = tid & 63, wave = __builtin_amdgcn_readfirstlane(tid >> 6);
    const int G = gridDim.x, bid = blockIdx.x;
    unsigned char* ws = a.ws;
    float* ssq0 = (float*)(ws + WS_SSQ); float* ssq1 = ssq0 + M; float* ssq2 = ssq1 + M; float* ssq3 = ssq2 + M;
    float* ssqh = (float*)(ws + WS_SSQH);
    bf16_t* W1GU = (bf16_t*)(ws + WS_W1GU); bf16_t* W1D = (bf16_t*)(ws + WS_W1D); bf16_t* WIN = (bf16_t*)(ws + WS_WIN); bf16_t* WOUT = (bf16_t*)(ws + WS_WOUT);
    bf16_t* W2GU = (bf16_t*)(ws + WS_W2GU); bf16_t* W2D = (bf16_t*)(ws + WS_W2D);
    bf16_t* MIX = (bf16_t*)(ws + WS_MIX); bf16_t* XB = (bf16_t*)(ws + WS_XB); float* OUN = (float*)(ws + WS_XB);
    bf16_t* HB = (bf16_t*)(ws + WS_BIG); bf16_t* PROJ = (bf16_t*)(ws + WS_BIG);
    bf16_t* OLOC = (bf16_t*)a.out;
    float* OLOC_unused = (float*)(ws + WS_XB); (void)OLOC_unused; float* TGS = (float*)(ws + WS_TG); float* CUMG = (float*)(ws + WS_CUM); float* DSEG = (float*)(ws + WS_DSEG);
    const float* x = a.in[0]; float* out = a.out;
    if (tid < 64) ((LAS unsigned*)(lds + LDS_CTL))[tid] = 0u;
    __syncthreads();
    const XcdBarrier xbar = xcd_barrier_post((unsigned*)(ws + WS_BAR), (volatile LAS unsigned*)(lds + LDS_CTL + 32));
#define GRID_BAR() do { if (a.use_cg) grid.sync(); else xcd_barrier(xbar); } while (0)

    {
        LAS float* scr = (LAS float*)(lds + wave * 16384);
        const int gw = bid * 8 + wave, NGW = G * 8;
        constexpr int I_GU = (D / 64) * (FF / 32), I_DN = (FF / 64) * (D / 32), I_IN = (D / 64) * (INC / 32), I_OUT = (D / 64) * (D / 32);
        constexpr int NITEMS = 4 * I_GU + 2 * I_DN + I_IN + I_OUT;
        auto desc = [&](int it) -> P0Desc {
            int r = it;
            if (r < I_GU) return P0Desc{a.in[2], W1GU, a.in[1], D, FF, 1, r}; r -= I_GU;
            if (r < I_GU) return P0Desc{a.in[3], W1GU, a.in[1], D, FF, 2, r}; r -= I_GU;
            if (r < I_DN) return P0Desc{a.in[4], W1D, nullptr, FF, D, 0, r}; r -= I_DN;
            if (r < I_IN) return P0Desc{a.in[6], WIN, a.in[5], D, INC, 3, r}; r -= I_IN;
            if (r < I_OUT) return P0Desc{a.in[10], WOUT, nullptr, D, D, 0, r}; r -= I_OUT;
            if (r < I_GU) return P0Desc{a.in[12], W2GU, a.in[11], D, FF, 1, r}; r -= I_GU;
            if (r < I_GU) return P0Desc{a.in[13], W2GU, a.in[11], D, FF, 2, r}; r -= I_GU;
            return P0Desc{a.in[14], W2D, nullptr, FF, D, 0, r};
        };
        {
            f32x4 va[8], vb[8]; float sa[8], sb[8];
            int it = gw;
            P0Desc da = desc(it < NITEMS ? it : 0), db = da;
            if (it < NITEMS) p0_load(da, va, sa, lane);
            while (it < NITEMS) {
                const int itb = it + NGW;
                if (itb < NITEMS) { db = desc(itb); p0_load(db, vb, sb, lane); }
                p0_finish(da, va, sa, scr, lane);
                if (itb >= NITEMS) break;
                const int ita = itb + NGW;
                if (ita < NITEMS) { da = desc(ita); p0_load(da, va, sa, lane); }
                p0_finish(db, vb, sb, scr, lane);
                it = ita;
            }
        }
        for (int m = gw; m < M; m += NGW) {
            const f32x4* xr = (const f32x4*)(x + (size_t)m * D) + lane; u32x2* o8 = (u32x2*)(XB + (size_t)m * D) + lane; float s = 0.f;
#pragma unroll
            for (int j = 0; j < 8; ++j) { const f32x4 v = xr[64 * j]; s += (v[0] * v[0] + v[1] * v[1]) + (v[2] * v[2] + v[3] * v[3]); u32x2 w; w.x = pk2(v[0], v[1]); w.y = pk2(v[2], v[3]); o8[64 * j] = w; }
            s = wave_sum(s);
            if (lane == 0) ssq0[m] = s;
        }
        for (int i = bid * 512 + tid; i < 3 * M; i += G * 512) ssq1[i] = 0.f;
    }
    GRID_BAR();

    { pg8::Gemm g{XB, W1GU, M, 2 * FF, D}; pg8::StaticOrder S; S.init(M, 2 * FF, G, bid); pg8::EpiSwiGLU E{HB, ssq0}; pg8::gemm_phase<pg8::EpiSwiGLU>(lds, g, S, E); }
    GRID_BAR();
    { pg8::Gemm g{HB, W1D, M, D, FF}; pg8::StaticOrder S; S.init(M, D, G, bid); pg8::EpiResid<true, true> E{nullptr, XB, nullptr, XB, ssq1, 0.5f}; pg8::gemm_phase<pg8::EpiResid<true, true>>(lds, g, S, E); }
    GRID_BAR();
    { pg8::Gemm g{XB, WIN, M, INC, D}; pg8::StaticOrder S; S.init(M, INC, G, bid); pg8::EpiProj E{PROJ, ssq1}; pg8::gemm_phase<pg8::EpiProj>(lds, g, S, E); }
    GRID_BAR();

    for (int item = bid; item < 256; item += G) hgrn_p1(lds, PROJ, a.in[7], OLOC, TGS, CUMG, DSEG, item, tid);
    {
        const float* cw = a.in[9];
        const size_t stride = (size_t)G * 512, total = (size_t)M * 128;
        const int c0 = (tid & 127) * 8;
        f32x4 wa[3], wb[3];
#pragma unroll
        for (int d = 0; d < 3; ++d) { wa[d] = *(const f32x4*)(cw + d * HW + c0); wb[d] = *(const f32x4*)(cw + d * HW + c0 + 4); }
        for (size_t idx0 = (size_t)bid * 512 + tid; idx0 < total; idx0 += 2 * stride) {
            u32x4 bb[2], cc[2][3]; float ok[2][3]; size_t rows[2]; bool have[2];
#pragma unroll
            for (int u = 0; u < 2; ++u) {
                const size_t idx = idx0 + u * stride; have[u] = idx < total;
                const size_t row = have[u] ? (idx >> 7) : (idx0 >> 7); rows[u] = row; const int t = (int)(row & (SEQ - 1));
                const bf16_t* pr = PROJ + row * INC;
                bb[u] = *(const u32x4*)(pr + 4 * HW + c0);
#pragma unroll
                for (int d = 0; d < 3; ++d) { const bool v = (t - 2 + d) >= 0; ok[u][d] = v ? 1.f : 0.f; const bf16_t* p2 = v ? pr - (size_t)(2 - d) * INC : pr;
                    cc[u][d] = *(const u32x4*)(p2 + 5 * HW + c0); }
            }
#pragma unroll
            for (int u = 0; u < 2; ++u) {
                float acc8[8];
#pragma unroll
                for (int j = 0; j < 8; ++j) acc8[j] = 0.f;
#pragma unroll
                for (int d = 0; d < 3; ++d) {
                    const u32x4 c4 = cc[u][d]; const float m = ok[u][d];
                    const float cv[8] = {bf_lo(c4.x), bf_hi(c4.x), bf_lo(c4.y), bf_hi(c4.y), bf_lo(c4.z), bf_hi(c4.z), bf_lo(c4.w), bf_hi(c4.w)};
#pragma unroll
                    for (int j = 0; j < 4; ++j) { acc8[j] += (wa[d][j] * m) * cv[j]; acc8[4 + j] += (wb[d][j] * m) * cv[4 + j]; }
                }
                const u32x4 b4 = bb[u];
                const float bv[8] = {bf_lo(b4.x), bf_hi(b4.x), bf_lo(b4.y), bf_hi(b4.y), bf_lo(b4.z), bf_hi(b4.z), bf_lo(b4.w), bf_hi(b4.w)};
                u32x4 w; w.x = pk2(bv[0] * acc8[0], bv[1] * acc8[1]); w.y = pk2(bv[2] * acc8[2], bv[3] * acc8[3]); w.z = pk2(bv[4] * acc8[4], bv[5] * acc8[5]); w.w = pk2(bv[6] * acc8[6], bv[7] * acc8[7]);
                if (have[u]) *(u32x4*)(MIX + rows[u] * D + HW + c0) = w;
            }
        }
    }
    GRID_BAR();
    for (int item = bid; item < 256; item += G) hgrn_p2(lds, PROJ, OLOC, TGS, CUMG, DSEG, a.in[8], MIX, item, tid);
    GRID_BAR();


    { pg8::Gemm g{MIX, WOUT, M, D, D}; pg8::StaticOrder S; S.init(M, D, G, bid); pg8::EpiResid<true, true> E{nullptr, XB, nullptr, XB, ssq2, 1.0f}; pg8::gemm_phase<pg8::EpiResid<true, true>>(lds, g, S, E); }
    GRID_BAR();
    { pg8::Gemm g{XB, W2GU, M, 2 * FF, D}; pg8::StaticOrder S; S.init(M, 2 * FF, G, bid); pg8::EpiSwiGLU E{HB, ssq2}; pg8::gemm_phase<pg8::EpiSwiGLU>(lds, g, S, E); }
    GRID_BAR();
    { pg8::Gemm g{HB, W2D, M, D, FF}; pg8::StaticOrder S; S.init(M, D, G, bid); pg8::EpiResid<true, true> E{nullptr, XB, nullptr, XB, ssq3, 0.5f}; pg8::gemm_phase<pg8::EpiResid<true, true>>(lds, g, S, E); }
    GRID_BAR();
    {
        const float* fw = a.in[15];
        for (size_t idx = (size_t)bid * 512 + tid; idx < (size_t)M * (D / 8); idx += (size_t)G * 512) {
            const size_t row = idx >> 8; const int c8 = (int)(idx & 255) * 8;
            const float rs = __builtin_amdgcn_rsqf(ssq3[row] * (1.0f / D) + EPS);
            const u32x4 xv = *(const u32x4*)(XB + row * D + c8); const f32x4 w0 = *(const f32x4*)(fw + c8), w1 = *(const f32x4*)(fw + c8 + 4);
            const f32x4 v0 = (f32x4){bf_lo(xv.x), bf_hi(xv.x), bf_lo(xv.y), bf_hi(xv.y)}, v1 = (f32x4){bf_lo(xv.z), bf_hi(xv.z), bf_lo(xv.w), bf_hi(xv.w)};
            *(f32x4*)(out + row * D + c8) = v0 * rs * w0; *(f32x4*)(out + row * D + c8 + 4) = v1 * rs * w1;
        }
    }
}

extern "C" void kernel_launch(void* const* d_in, const int* in_sizes, int n_in, void* d_out, int out_size,
                              void* d_ws, size_t ws_size, hipStream_t stream) {
    static int grid = 0;
    if (grid == 0) {
        if (n_in != 16 || in_sizes[0] != M * D || out_size != M * D || ws_size < WS_END) { fprintf(stderr, "kernel_launch: unexpected shapes / workspace (%d inputs, ws %zu)\n", n_in, ws_size); grid = -1; return; }
        int dev = 0, cus = 0, per_cu = 0;
        (void)hipGetDevice(&dev);
        (void)hipDeviceGetAttribute(&cus, hipDeviceAttributeMultiprocessorCount, dev);
        (void)hipFuncSetAttribute((const void*)mk_fwd, hipFuncAttributeMaxDynamicSharedMemorySize, LDS_BYTES);
        (void)hipOccupancyMaxActiveBlocksPerMultiprocessor(&per_cu, (const void*)mk_fwd, 512, LDS_BYTES);
        if (per_cu < 1) { fprintf(stderr, "kernel_launch: occupancy query says %d\n", per_cu); per_cu = 1; }
        grid = cus * per_cu;
    }
    if (grid < 0) return;
    Args a{};
    for (int i = 0; i < 16; ++i) a.in[i] = (const float*)d_in[i];
    a.out = (float*)d_out; a.ws = (unsigned char*)d_ws; a.use_cg = 0; a.pad = 0;
    if (hipMemsetAsync((char*)d_ws + WS_BAR, 0, BAR_BYTES, stream) != hipSuccess) { fprintf(stderr, "kernel_launch: memset failed\n"); return; }
    void* args[] = {&a};
    hipError_t e = hipLaunchCooperativeKernel((const void*)mk_fwd, dim3(grid), dim3(512), args, LDS_BYTES, stream);
    if (e != hipSuccess) fprintf(stderr, "cooperative launch failed: %s (grid %d)\n", hipGetErrorString(e), grid);
}
```

```cpp
#include <hip/hip_runtime.h>
#include <hip/hip_cooperative_groups.h>
#include <cstdio>
#include <cstdint>
namespace cg = cooperative_groups;

#define LAS __attribute__((address_space(3)))
typedef unsigned short bf16_t;
typedef short bf16x8 __attribute__((ext_vector_type(8)));
typedef float f32x4 __attribute__((ext_vector_type(4)));
typedef float f32x2 __attribute__((ext_vector_type(2)));
typedef unsigned u32x4 __attribute__((ext_vector_type(4)));
typedef unsigned u32x2 __attribute__((ext_vector_type(2)));

constexpr int D = 2048, M = 16384, SEQ = 2048, FF = 5632, HW = 1024, NHEAD = 8, HD = 128, INC = 7168;
constexpr float EPS = 1e-6f;
constexpr size_t MiB = 1u << 20;
constexpr size_t WS_SSQ = 0;
constexpr size_t WS_BAR = 1 * MiB, BAR_BYTES = 16384;
constexpr size_t WS_SSQH = 2 * MiB;
constexpr size_t WS_W1GU = 4 * MiB, WS_W1D = 48 * MiB, WS_WIN = 70 * MiB, WS_WOUT = 98 * MiB, WS_W2GU = 106 * MiB, WS_W2D = 150 * MiB;
constexpr size_t WS_MIX = 4 * MiB;
constexpr size_t WS_XB = 172 * MiB;
constexpr size_t WS_BIG = 236 * MiB;
constexpr size_t WS_TG = 460 * MiB;
constexpr size_t WS_CUM = 476 * MiB;
constexpr size_t WS_DSEG = 477 * MiB;
constexpr size_t WS_END = 478 * MiB;
constexpr int LDS_BYTES = 147456, LDS_CTL = 131072;

__device__ __forceinline__ unsigned f2bf(float f) { unsigned u = __builtin_bit_cast(unsigned, f); return (u + 0x7fffu + ((u >> 16) & 1u)) >> 16; }
__device__ __forceinline__ unsigned pk2(float lo, float hi) { return f2bf(lo) | (f2bf(hi) << 16); }
__device__ __forceinline__ float bf_lo(unsigned w) { return __builtin_bit_cast(float, w << 16); }
__device__ __forceinline__ float bf_hi(unsigned w) { return __builtin_bit_cast(float, w & 0xffff0000u); }
__device__ __forceinline__ float sigmoidf_(float x) { return __builtin_amdgcn_rcpf(1.0f + __builtin_amdgcn_exp2f(-1.4426950408889634f * x)); }
__device__ __forceinline__ float siluf_(float x) { return x * sigmoidf_(x); }

namespace pg8 {
constexpr int BM = 256, BK = 64, HALF = 128, HTB = HALF * BK * 2, STAGE_BYTES = 8 * HTB, NXCD = 8, WGM = 4;
__host__ __device__ __forceinline__ int lds_byte(int r, int c) { const int st = (r >> 4) * 2 + (c >> 5), rr = r & 15, cc = c & 31, ob = rr * 64 + cc * 2; return st * 1024 + (ob ^ (((ob >> 9) & 1) << 5)); }
__host__ __device__ __forceinline__ void stage_rc(int b, int& R, int& C) { const int st = b / 1024, sb = b % 1024, swz = sb ^ (((sb >> 9) & 1) << 5); R = (st >> 1) * 16 + swz / 64; C = (st & 1) * 32 + (swz % 64) / 2; }
__host__ __device__ __forceinline__ int perm32(int rho) { const int n = rho >> 4, i = rho & 15; return 8 * (i >> 2) + 4 * n + (i & 3); }

struct Unit { int pm, pn; };
struct Gemm { const bf16_t* A; const bf16_t* Bt; int M, N, K; };

struct StaticOrder {
    int nM, nN, nwg, G, c;
    __host__ __device__ void init(int M_, int N_, int G_, int c_) { nM = M_ / BM; nN = N_ / BM; nwg = nM * nN; G = G_; c = c_; }
    __host__ __device__ bool next(int i, Unit& u) const {
        const long L = (long)i * G + c; if (L >= nwg) return false;
        int wgid = (int)L; { const int q = nwg / NXCD, r = nwg % NXCD, xcd = wgid % NXCD, off = wgid / NXCD; wgid = (xcd < r ? xcd * (q + 1) : r * (q + 1) + (xcd - r) * q) + off; }
        const int nig = WGM * nN, gid = wgid / nig, fm = gid * WGM, gsz = (nM - fm) < WGM ? (nM - fm) : WGM;
        u.pm = fm + ((wgid % nig) % gsz); u.pn = (wgid % nig) / gsz; return true;
    }
};

typedef __bf16 bf16x2_t __attribute__((ext_vector_type(2)));
__device__ __forceinline__ unsigned cvt_pk_bf16(float lo, float hi) { const f32x2 v = {lo, hi}; const bf16x2_t b = __builtin_convertvector(v, bf16x2_t); return __builtin_bit_cast(unsigned, b); }

struct EpiSwiGLU {
    static constexpr bool PERM = true;
    bf16_t* O; const float* ssq;
    __device__ __forceinline__ void operator()(const f32x4 (&acc)[2][2][4][2], const Unit& u, int wr, int wc, int fr, int fq) const {
        const int row0 = u.pm * BM + wr * 64 + fr, col0 = u.pn * HALF + wc * 32 + 8 * fq;
        float rsv[2][4];
#pragma unroll
        for (int ai = 0; ai < 2; ++ai)
#pragma unroll
            for (int m = 0; m < 4; ++m) rsv[ai][m] = ssq[row0 + ai * HALF + m * 16];
        __builtin_amdgcn_sched_barrier(0);
#pragma unroll
        for (int ai = 0; ai < 2; ++ai)
#pragma unroll
            for (int m = 0; m < 4; ++m) {
                const int row = row0 + ai * HALF + m * 16;
                const float rs = __builtin_amdgcn_rsqf(rsv[ai][m] * (1.0f / D) + EPS);
                f32x4 h0, h1;
#pragma unroll
                for (int j = 0; j < 4; ++j) { h0[j] = siluf_(acc[ai][0][m][0][j] * rs) * (acc[ai][1][m][0][j] * rs); h1[j] = siluf_(acc[ai][0][m][1][j] * rs) * (acc[ai][1][m][1][j] * rs); }
                u32x4 w; w.x = cvt_pk_bf16(h0[0], h0[1]); w.y = cvt_pk_bf16(h0[2], h0[3]); w.z = cvt_pk_bf16(h1[0], h1[1]); w.w = cvt_pk_bf16(h1[2], h1[3]);
                __builtin_nontemporal_store(w, (u32x4*)(O + (size_t)row * FF + col0));
            }
    }
};
struct EpiProj {
    static constexpr bool PERM = true;
    bf16_t* O; const float* ssq;
    __device__ __forceinline__ void operator()(const f32x4 (&acc)[2][2][4][2], const Unit& u, int wr, int wc, int fr, int fq) const {
        const int row0 = u.pm * BM + wr * 64 + fr, col0 = u.pn * BM + wc * 32 + 8 * fq;
        float rsv[2][4];
#pragma unroll
        for (int ai = 0; ai < 2; ++ai)
#pragma unroll
            for (int m = 0; m < 4; ++m) rsv[ai][m] = ssq[row0 + ai * HALF + m * 16];
        __builtin_amdgcn_sched_barrier(0);
#pragma unroll
        for (int ai = 0; ai < 2; ++ai)
#pragma unroll
            for (int m = 0; m < 4; ++m) {
                const int row = row0 + ai * HALF + m * 16;
                const float rs = __builtin_amdgcn_rsqf(rsv[ai][m] * (1.0f / D) + EPS);
                if (u.pn >= 20) {
                    const float rs2 = rs * rs;
                    const f32x4 v0 = acc[ai][0][m][0] * acc[ai][1][m][0] * rs2, v1 = acc[ai][0][m][1] * acc[ai][1][m][1] * rs2;
                    u32x4 w; w.x = cvt_pk_bf16(v0[0], v0[1]); w.y = cvt_pk_bf16(v0[2], v0[3]); w.z = cvt_pk_bf16(v1[0], v1[1]); w.w = cvt_pk_bf16(v1[2], v1[3]);
                    *(u32x4*)(O + (size_t)row * INC + 5 * HW + (u.pn - 20) * HALF + wc * 32 + 8 * fq) = w;
                } else {
#pragma unroll
                for (int bj = 0; bj < 2; ++bj) { const f32x4 v0 = acc[ai][bj][m][0] * rs, v1 = acc[ai][bj][m][1] * rs;
                    u32x4 w; w.x = cvt_pk_bf16(v0[0], v0[1]); w.y = cvt_pk_bf16(v0[2], v0[3]); w.z = cvt_pk_bf16(v1[0], v1[1]); w.w = cvt_pk_bf16(v1[2], v1[3]);
                    *(u32x4*)(O + (size_t)row * INC + col0 + bj * HALF) = w; }
                }
            }
    }
};
template <bool BASE_BF, bool OUT_BF> struct EpiResid {
    static constexpr bool PERM = true;
    const float* basef; const bf16_t* baseb; float* outf; bf16_t* outb; float* ssq; float scale;
    __device__ __forceinline__ void operator()(const f32x4 (&acc)[2][2][4][2], const Unit& u, int wr, int wc, int fr, int fq) const {
        const int row0 = u.pm * BM + wr * 64 + fr, col0 = u.pn * BM + wc * 32 + 8 * fq;
#pragma unroll
        for (int ai = 0; ai < 2; ++ai) {
            f32x4 b[4][2][2];
#pragma unroll
            for (int m = 0; m < 4; ++m) { const size_t off = (size_t)(row0 + ai * HALF + m * 16) * D + col0;
#pragma unroll
                for (int bj = 0; bj < 2; ++bj) {
                    if (BASE_BF) { const u32x4 w = *(const u32x4*)(baseb + off + bj * HALF);
                        b[m][bj][0] = (f32x4){bf_lo(w.x), bf_hi(w.x), bf_lo(w.y), bf_hi(w.y)}; b[m][bj][1] = (f32x4){bf_lo(w.z), bf_hi(w.z), bf_lo(w.w), bf_hi(w.w)}; }
                    else { b[m][bj][0] = *(const f32x4*)(basef + off + bj * HALF); b[m][bj][1] = *(const f32x4*)(basef + off + bj * HALF + 4); } } }
            __builtin_amdgcn_sched_barrier(0);
#pragma unroll
            for (int m = 0; m < 4; ++m) {
                const int row = row0 + ai * HALF + m * 16; const size_t off = (size_t)row * D + col0; float s = 0.f;
#pragma unroll
                for (int bj = 0; bj < 2; ++bj) {
                    const f32x4 v0 = b[m][bj][0] + acc[ai][bj][m][0] * scale, v1 = b[m][bj][1] + acc[ai][bj][m][1] * scale;
                    s += ((v0[0] * v0[0] + v0[1] * v0[1]) + (v0[2] * v0[2] + v0[3] * v0[3])) + ((v1[0] * v1[0] + v1[1] * v1[1]) + (v1[2] * v1[2] + v1[3] * v1[3]));
                    if (OUT_BF) { u32x4 w; w.x = cvt_pk_bf16(v0[0], v0[1]); w.y = cvt_pk_bf16(v0[2], v0[3]); w.z = cvt_pk_bf16(v1[0], v1[1]); w.w = cvt_pk_bf16(v1[2], v1[3]); __builtin_nontemporal_store(w, (u32x4*)(outb + off + bj * HALF)); }
                    else { *(f32x4*)(outf + off + bj * HALF) = v0; *(f32x4*)(outf + off + bj * HALF + 4) = v1; }
                }
                s += __shfl_xor(s, 16); s += __shfl_xor(s, 32);
                if (fq == 0) (void)__hip_atomic_fetch_add(ssq + row, s, __ATOMIC_RELAXED, __HIP_MEMORY_SCOPE_AGENT);
            }
            asm volatile("" ::: "memory");
        }
    }
};

template <class Epi, bool ALIGN_EPI = true, bool SP2 = true>
__device__ __forceinline__ void gemm_phase(LAS unsigned char* lds, const Gemm g, const StaticOrder& S, const Epi& E) {
    int tid = threadIdx.x; asm volatile("" : "+v"(tid));
    const int wid = __builtin_amdgcn_readfirstlane(tid >> 6), lane = tid & 63, wr = wid >> 2, wc = wid & 3, fr = lane & 15, fq = lane >> 4;
    const int K = g.K, nt = K / BK;
    unsigned voffA[2], voffB[2];
#pragma unroll
    for (int i = 0; i < 2; ++i) { int R, C; stage_rc(tid * 16 + i * 8192, R, C); const int Rb = Epi::PERM ? ((R & ~31) + perm32(R & 31)) : R;
        voffA[i] = (unsigned)(R * K + C) * 2u; voffB[i] = (unsigned)(Rb * K + C) * 2u; }
    const size_t kstep = (size_t)(BK * 2);
    const size_t hstep = (size_t)HALF * K * 2;
    const size_t tstep = 2 * hstep;
    const unsigned ldsw = (unsigned)wid * 1024u;
    const int aoff = lds_byte(wr * 64 + fr, fq * 8), boff = lds_byte(wc * 32 + fr, fq * 8);
#define PG8_SA(b, h) (((b) * 2 + (h)) * HTB)
#define PG8_SB(b, h) ((4 + (b) * 2 + (h)) * HTB)
#define PG8_STAGE(bufoff, gbase, voff) do { _Pragma("unroll") for (int _i = 0; _i < 2; ++_i) \
        __builtin_amdgcn_global_load_lds((const unsigned*)((const char*)(gbase) + (voff)[_i]), (LAS unsigned*)(lds + (bufoff) + ldsw + _i * 8192), 16, 0, 0); } while (0)
#define PG8_LDA(dst, b, h) do { _Pragma("unroll") for (int m = 0; m < 4; ++m) _Pragma("unroll") for (int k = 0; k < 2; ++k) dst[m][k] = *(const LAS bf16x8*)(lds + PG8_SA(b, h) + aoff + m * 2048 + k * 1024); } while (0)
#define PG8_LDB(dst, b, h) do { _Pragma("unroll") for (int n = 0; n < 2; ++n) _Pragma("unroll") for (int k = 0; k < 2; ++k) dst[n][k] = *(const LAS bf16x8*)(lds + PG8_SB(b, h) + boff + n * 2048 + k * 1024); } while (0)
#define PG8_MMA(ai, bj, At, Bt) do { __builtin_amdgcn_s_setprio(1); _Pragma("unroll") for (int m = 0; m < 4; ++m) _Pragma("unroll") for (int n = 0; n < 2; ++n) _Pragma("unroll") for (int k = 0; k < 2; ++k) \
        acc[ai][bj][m][n] = __builtin_amdgcn_mfma_f32_16x16x32_bf16(Bt[n][k], At[m][k], acc[ai][bj][m][n], 0, 0, 0); __builtin_amdgcn_s_setprio(0); } while (0)
#define PG8_WAIT_V(n) asm volatile("s_waitcnt vmcnt(" #n ")" ::: "memory")
#define PG8_WAIT_L(n) asm volatile("s_waitcnt lgkmcnt(" #n ")" ::: "memory")
#define PG8_BAR __builtin_amdgcn_s_barrier()
#define PG8_SCHED __builtin_amdgcn_sched_barrier(0)
    Unit cur, nxt; int ui = 0;
    if (!S.next(0, cur)) return;
    f32x4 acc[2][2][4][2];
#pragma unroll
    for (int a = 0; a < 2; ++a)
#pragma unroll
        for (int b = 0; b < 2; ++b)
#pragma unroll
            for (int m = 0; m < 4; ++m)
#pragma unroll
                for (int n = 0; n < 2; ++n) acc[a][b][m][n] = (f32x4){0.f, 0.f, 0.f, 0.f};
    bf16x8 At[4][2], B0[2][2], B1[2][2];
    const char* cA = (const char*)g.A + (size_t)cur.pm * tstep; const char* cB = (const char*)g.Bt + (size_t)cur.pn * tstep;
    if constexpr (SP2) {
        PG8_STAGE(PG8_SB(0, 0), cB, voffB); PG8_STAGE(PG8_SB(0, 1), cB + hstep, voffB); PG8_STAGE(PG8_SA(0, 0), cA, voffA); PG8_STAGE(PG8_SA(0, 1), cA + hstep, voffA);
        if (wr == 1) PG8_BAR;
        PG8_WAIT_V(2); PG8_BAR;
        PG8_STAGE(PG8_SB(1, 0), cB + kstep, voffB); PG8_STAGE(PG8_SA(1, 0), cA + kstep, voffA); PG8_STAGE(PG8_SB(1, 1), cB + hstep + kstep, voffB);
        PG8_WAIT_V(6); PG8_BAR;
    } else {
        PG8_STAGE(PG8_SB(0, 0), cB, voffB); PG8_STAGE(PG8_SA(0, 0), cA, voffA); PG8_STAGE(PG8_SB(0, 1), cB + hstep, voffB); PG8_STAGE(PG8_SA(0, 1), cA + hstep, voffA);
        if (wr == 1) PG8_BAR;
        PG8_WAIT_V(4); PG8_BAR;
        PG8_STAGE(PG8_SB(1, 0), cB + kstep, voffB); PG8_STAGE(PG8_SA(1, 0), cA + kstep, voffA); PG8_STAGE(PG8_SB(1, 1), cB + hstep + kstep, voffB);
        PG8_WAIT_V(6); PG8_BAR;
    }
    for (;;) {
        const bool has_next = S.next(ui + 1, nxt);
        const char* nA = has_next ? (const char*)g.A + (size_t)nxt.pm * tstep : cA; const char* nB = has_next ? (const char*)g.Bt + (size_t)nxt.pn * tstep : cB;
        for (int t = 0; t < nt; t += 2) {
            const bool last = (t == nt - 2);
            const char* a1 = cA + (size_t)(t + 1) * kstep;
            const char* a2 = last ? nA : cA + (size_t)(t + 2) * kstep; const char* b2 = last ? nB : cB + (size_t)(t + 2) * kstep;
            const char* a3 = a2 + kstep; const char* b3 = b2 + kstep;
            if constexpr (SP2) {
            PG8_LDB(B0, 0, 0); PG8_LDB(B1, 0, 1); PG8_SCHED; PG8_LDA(At, 0, 0); PG8_STAGE(PG8_SA(1, 1), a1 + hstep, voffA);
            PG8_WAIT_V(8); PG8_WAIT_L(0); PG8_BAR; PG8_MMA(0, 0, At, B0); PG8_MMA(0, 1, At, B1); PG8_BAR; PG8_SCHED;
            PG8_LDA(At, 0, 1); PG8_STAGE(PG8_SB(0, 0), b2, voffB); PG8_STAGE(PG8_SB(0, 1), b2 + hstep, voffB); PG8_STAGE(PG8_SA(0, 0), a2, voffA);
            PG8_WAIT_V(8); PG8_WAIT_L(0); PG8_BAR; PG8_MMA(1, 0, At, B0); PG8_MMA(1, 1, At, B1); PG8_BAR; PG8_SCHED;
            PG8_LDB(B0, 1, 0); PG8_LDB(B1, 1, 1); PG8_SCHED; PG8_LDA(At, 1, 0); PG8_STAGE(PG8_SA(0, 1), a2 + hstep, voffA);
            PG8_WAIT_V(8); PG8_WAIT_L(0); PG8_BAR; PG8_MMA(0, 0, At, B0); PG8_MMA(0, 1, At, B1); PG8_BAR; PG8_SCHED;
            PG8_LDA(At, 1, 1); PG8_STAGE(PG8_SB(1, 0), b3, voffB); PG8_STAGE(PG8_SB(1, 1), b3 + hstep, voffB); PG8_STAGE(PG8_SA(1, 0), a3, voffA);
            PG8_WAIT_V(8); PG8_WAIT_L(0); PG8_BAR; PG8_MMA(1, 0, At, B0); PG8_MMA(1, 1, At, B1); PG8_BAR; PG8_SCHED;
            } else {
            PG8_LDB(B0, 0, 0); PG8_SCHED; PG8_LDA(At, 0, 0); PG8_STAGE(PG8_SA(1, 1), a1 + hstep, voffA);
            PG8_WAIT_L(8); PG8_BAR; PG8_WAIT_L(0); PG8_MMA(0, 0, At, B0); PG8_BAR; PG8_SCHED;
            PG8_LDB(B1, 0, 1); PG8_STAGE(PG8_SB(0, 0), b2, voffB);
            PG8_BAR; PG8_WAIT_L(0); PG8_MMA(0, 1, At, B1); PG8_BAR;
            PG8_LDA(At, 0, 1); PG8_STAGE(PG8_SA(0, 0), a2, voffA);
            PG8_BAR; PG8_WAIT_L(0); PG8_MMA(1, 0, At, B0); PG8_BAR; PG8_SCHED;
            PG8_STAGE(PG8_SB(0, 1), b2 + hstep, voffB);
            PG8_WAIT_V(6); PG8_BAR; PG8_MMA(1, 1, At, B1); PG8_BAR;
            PG8_LDB(B0, 1, 0); PG8_SCHED; PG8_LDA(At, 1, 0); PG8_STAGE(PG8_SA(0, 1), a2 + hstep, voffA);
            PG8_WAIT_L(8); PG8_BAR; PG8_WAIT_L(0); PG8_MMA(0, 0, At, B0); PG8_BAR; PG8_SCHED;
            PG8_LDB(B1, 1, 1); PG8_STAGE(PG8_SB(1, 0), b3, voffB);
            PG8_BAR; PG8_WAIT_L(0); PG8_MMA(0, 1, At, B1); PG8_BAR;
            PG8_LDA(At, 1, 1); PG8_STAGE(PG8_SA(1, 0), a3, voffA);
            PG8_BAR; PG8_WAIT_L(0); PG8_MMA(1, 0, At, B0); PG8_BAR; PG8_SCHED;
            PG8_STAGE(PG8_SB(1, 1), b3 + hstep, voffB);
            PG8_WAIT_V(6); PG8_BAR; PG8_MMA(1, 1, At, B1); PG8_BAR;
            }
        }
        if constexpr (ALIGN_EPI) { if (wr == 0) PG8_BAR; }
        E(acc, cur, wr, wc, fr, fq);
        if (!has_next) break;
#pragma unroll
        for (int a = 0; a < 2; ++a)
#pragma unroll
            for (int b = 0; b < 2; ++b)
#pragma unroll
                for (int m = 0; m < 4; ++m)
#pragma unroll
                    for (int n = 0; n < 2; ++n) acc[a][b][m][n] = (f32x4){0.f, 0.f, 0.f, 0.f};
        cur = nxt; cA = nA; cB = nB; ++ui;
        if constexpr (ALIGN_EPI) { if (wr == 1) PG8_BAR; }
    }
    PG8_WAIT_V(0);
    if constexpr (!ALIGN_EPI) { if (wr == 0) PG8_BAR; }
    PG8_BAR;
#undef PG8_SA
#undef PG8_SB
#undef PG8_STAGE
#undef PG8_LDA
#undef PG8_LDB
#undef PG8_MMA
#undef PG8_WAIT_V
#undef PG8_WAIT_L
#undef PG8_BAR
#undef PG8_SCHED
}
}

#define LDS_WAIT() asm volatile("s_waitcnt lgkmcnt(0)" ::: "memory")
__device__ __forceinline__ float wave_sum(float v) {
#pragma unroll
    for (int o = 1; o < 64; o <<= 1) v += __shfl_xor(v, o);
    return v;
}
struct P0Desc { const float* W; bf16_t* WT; const float* ks; int K, N, mode, item; };
__device__ __forceinline__ void p0_load(const P0Desc& d, f32x4 (&v)[8], float (&sc)[8], int lane) {
    const int nblk = d.N / 32, kb = d.item / nblk, nb = d.item % nblk, k0 = 64 * kb, n0 = 32 * nb, kr = lane >> 3, nc = (lane & 7) * 4;
#pragma unroll
    for (int i = 0; i < 8; ++i) { v[i] = __builtin_nontemporal_load((const f32x4*)(d.W + (size_t)(k0 + kr + 8 * i) * d.N + n0 + nc)); sc[i] = d.ks ? d.ks[k0 + kr + 8 * i] : 1.0f; }
}
__device__ __forceinline__ void p0_finish(const P0Desc& d, const f32x4 (&v)[8], const float (&sc)[8], LAS float* scr, int lane) {
    const int nblk = d.N / 32, kb = d.item / nblk, nb = d.item % nblk, k0 = 64 * kb, n0 = 32 * nb, kr = lane >> 3, nc = (lane & 7) * 4;
#pragma unroll
    for (int i = 0; i < 8; ++i) { LAS float* p = scr + (kr + 8 * i) * 33 + nc; p[0] = v[i][0] * sc[i]; p[1] = v[i][1] * sc[i]; p[2] = v[i][2] * sc[i]; p[3] = v[i][3] * sc[i]; }
    LDS_WAIT(); asm volatile("" ::: "memory");
    const int c = lane & 7;
    int rb;
    if (d.mode == 0) rb = n0;
    else if (d.mode == 3) rb = (n0 < 5 * HW) ? n0 : ((n0 < 6 * HW) ? 5 * HW + (((n0 - 5 * HW) >> 7) * 256) + ((n0 - 5 * HW) & 127) : 5 * HW + (((n0 - 6 * HW) >> 7) * 256) + 128 + ((n0 - 6 * HW) & 127));
    else rb = (n0 >> 7) * 256 + (d.mode == 2 ? 128 : 0) + (n0 & 127);
#pragma unroll
    for (int j = 0; j < 4; ++j) { const int n = (lane >> 3) + 8 * j; const LAS float* sp = scr + (8 * c) * 33 + n;
        u32x4 o; o.x = pk2(sp[0 * 33], sp[1 * 33]); o.y = pk2(sp[2 * 33], sp[3 * 33]); o.z = pk2(sp[4 * 33], sp[5 * 33]); o.w = pk2(sp[6 * 33], sp[7 * 33]);
        *(u32x4*)(d.WT + (size_t)(rb + n) * d.K + k0 + 8 * c) = o; }
    LDS_WAIT(); asm volatile("" ::: "memory");
}


#define XB_TMO      128
#define XB_XCNT(j)  (256  + 64 * (j))
#define XB_XSUB(j)  (1280 + 64 * (j))
#define XB_XGEN(j)  (2304 + 64 * (j))
#define XB_TOP      3328
#define XB_TOPGEN   3392
#define XCD_BAR_WORDS 3456
#define XB_SPIN_CAP (1u << 18)
__device__ __forceinline__ unsigned xb_ld(unsigned* p)              { return __hip_atomic_load(p, __ATOMIC_RELAXED, __HIP_MEMORY_SCOPE_AGENT); }
__device__ __forceinline__ unsigned xb_add(unsigned* p, unsigned v) { return __hip_atomic_fetch_add(p, v, __ATOMIC_RELAXED, __HIP_MEMORY_SCOPE_AGENT); }
__device__ __forceinline__ unsigned xb_xcc_id() { return (unsigned)__builtin_amdgcn_s_getreg((3 << 11) | 20) & 0xFu; }
#define XB_SPIN(cond, bar) do { unsigned _sp = 0; while (cond) { __builtin_amdgcn_s_sleep(1); \
    if ((++_sp & 255u) == 0u) { if (xb_ld(&(bar)[XB_TMO])) break; if (_sp > XB_SPIN_CAP) { atomicAdd(&(bar)[XB_TMO], 1u); break; } } } } while (0)
struct XcdBarrier { unsigned* bar; unsigned x; volatile LAS unsigned* st; };
__device__ __forceinline__ XcdBarrier xcd_barrier_post(unsigned* bar, volatile LAS unsigned* st) {
    XcdBarrier b; b.bar = bar; b.x = xb_xcc_id(); b.st = st;
    if (threadIdx.x == 0) (void)xb_add(&bar[XB_XCNT(b.x)], 1u);
    return b;
}
__device__ __forceinline__ void xcd_barrier_complete(unsigned* bar, unsigned x, unsigned& nloc, unsigned& nx) {
    const unsigned G = gridDim.x * gridDim.y * gridDim.z;
    unsigned sum, cnt, mine, sp = 0u;
    for (;;) {
        sum = 0u; cnt = 0u; mine = 0u;
#pragma unroll
        for (unsigned j = 0; j < 16; ++j) { const unsigned c = xb_ld(&bar[XB_XCNT(j)]); sum += c; cnt += (c > 0u) ? 1u : 0u; mine = (j == x) ? c : mine; }
        if (sum == G) break;
        __builtin_amdgcn_s_sleep(1);
        if ((++sp & 255u) == 0u) { if (xb_ld(&bar[XB_TMO])) break; if (sp > XB_SPIN_CAP) { atomicAdd(&bar[XB_TMO], 1u); break; } }
    }
    nloc = mine > 0u ? mine : 1u; nx = cnt > 0u ? cnt : 1u;
}
__device__ __forceinline__ void xcd_barrier(const XcdBarrier& b) {
    asm volatile("s_waitcnt vmcnt(0)" ::: "memory");
    __syncthreads();
    if (threadIdx.x == 0) {
        unsigned* bar = b.bar;
        __builtin_amdgcn_s_waitcnt(0);
        unsigned nloc = b.st[0], nx = b.st[1];
        if (nloc == 0u) { xcd_barrier_complete(bar, b.x, nloc, nx); b.st[0] = nloc; b.st[1] = nx; }
        const unsigned old = xb_add(&bar[XB_XSUB(b.x)], 1u);
        const unsigned gen = old / nloc;
        if (old + 1u == (gen + 1u) * nloc) {
            __builtin_amdgcn_fence(__ATOMIC_RELEASE, "agent");
            asm volatile("s_waitcnt vmcnt(0)" ::: "memory");
            const unsigned og = xb_add(&bar[XB_TOP], 1u);
            const unsigned tg = og / nx;
            if (og + 1u == (tg + 1u) * nx) xb_add(&bar[XB_TOPGEN], 1u);
            else XB_SPIN(xb_ld(&bar[XB_TOPGEN]) == tg, bar);
            __builtin_amdgcn_fence(__ATOMIC_ACQUIRE, "agent");
            xb_add(&bar[XB_XGEN(b.x)], 1u);
            asm volatile("s_waitcnt vmcnt(0)" ::: "memory");
        } else {
            XB_SPIN(xb_ld(&bar[XB_XGEN(b.x)]) == gen, bar);
            __builtin_amdgcn_fence(__ATOMIC_ACQUIRE, "agent");
            asm volatile("s_waitcnt vmcnt(0)" ::: "memory");
        }
    }
    __syncthreads();
}


__device__ __forceinline__ void hgrn_p1(LAS unsigned char* lds, bf16_t* PROJ, const float* lbl, bf16_t* OLOC, float* TG, float* CUMG, float* DSEG, int item, int tid_in) {
    int tid = tid_in; asm volatile("" : "+v"(tid));
    constexpr int QS = 272, TS = 144;
    LAS unsigned char* Qd = lds;
    LAS unsigned char* Kd = lds + 17408;
    LAS unsigned char* KsT = lds + 34816;
    LAS unsigned char* VT = KsT + 18432;
    LAS unsigned char* ST = VT + 18432;
    LAS unsigned char* Pm = ST + 34816;
    LAS unsigned char* GT = Pm + 9216;
    LAS unsigned char* DEC = GT + 4096;
    const int lane = tid & 63, w = __builtin_amdgcn_readfirstlane(tid >> 6), r = lane & 15, q = lane >> 4;
    const int b = item >> 5, h = (item >> 2) & 7, g = item & 3;
    const size_t row0 = (size_t)b * SEQ + (size_t)g * 512;
    const int kp = lane, tg = w;
    const int ci = w & 3, vh = w >> 2;
    const float lb0 = sigmoidf_(lbl[h * HD + 2 * kp] - lbl[HW + h * HD + 2 * kp]), lb1 = sigmoidf_(lbl[h * HD + 2 * kp + 1] - lbl[HW + h * HD + 2 * kp + 1]);
    __syncthreads();
    for (int i = tid; i < 34816 / 16; i += 512) *(LAS u32x4*)(ST + i * 16) = (u32x4){0u, 0u, 0u, 0u};
    f32x4 accS[8];
#pragma unroll
    for (int i = 0; i < 8; ++i) accS[i] = (f32x4){0.f, 0.f, 0.f, 0.f};
    char* sbase = (char*)(PROJ + (row0 + 8 * tg) * INC + h * HD);
    const unsigned voff = 4u * (unsigned)kp;
    float cum0 = 1.f, cum1 = 1.f;
    float* cumg = CUMG + ((size_t)(b * 8 + h) * 32 + g * 8) * 128 + 2 * kp;
    unsigned rq[8], rf[8], rv[8];
#pragma unroll
    for (int i = 0; i < 8; ++i) { const char* p = sbase + (size_t)i * INC * 2; rq[i] = *(const unsigned*)(p + voff); rf[i] = *(const unsigned*)(p + HW * 2 + voff); rv[i] = *(const unsigned*)(p + 4 * HW + voff); }
    for (int n = 0; n < 8; ++n) {
        f32x2 fv[8], cpv[8]; f32x2 cc = {1.f, 1.f};
        const f32x2 lbv = {lb0, lb1}, omlb = {1.f - lb0, 1.f - lb1};
#pragma unroll
        for (int i = 0; i < 8; ++i) {
            const f32x2 xv = {bf_lo(rf[i]), bf_hi(rf[i])}; const f32x2 tv = xv * (-1.4426950408889634f);
            f32x2 ev; ev.x = __builtin_amdgcn_exp2f(tv.x); ev.y = __builtin_amdgcn_exp2f(tv.y);
            const f32x2 dv = ev + 1.0f; f32x2 sv; sv.x = __builtin_amdgcn_rcpf(dv.x); sv.y = __builtin_amdgcn_rcpf(dv.y);
            fv[i] = lbv + omlb * sv; cc = cc * fv[i]; cpv[i] = cc;
        }
        *(LAS f32x2*)(GT + (tg * 128 + 2 * kp) * 4) = cc;
        __syncthreads();
        f32x2 prev = {1.f, 1.f}, totv = {1.f, 1.f};
#pragma unroll
        for (int gg = 0; gg < 8; ++gg) { const f32x2 gv = *(const LAS f32x2*)(GT + (gg * 128 + 2 * kp) * 4); if (gg < tg) prev = prev * gv; totv = totv * gv; }
        {
            f32x2 rP[8];
            {   const f32x2 p7 = prev * cpv[7]; rP[7].x = __builtin_amdgcn_rcpf(fmaxf(p7.x, 1e-30f)); rP[7].y = __builtin_amdgcn_rcpf(fmaxf(p7.y, 1e-30f)); }
#pragma unroll
            for (int i = 6; i >= 0; --i) rP[i] = rP[i + 1] * fv[i + 1];
            f32x2 ksv[8];
#pragma unroll
            for (int i = 0; i < 8; ++i) {
                const f32x2 Pv = prev * cpv[i];
                const f32x2 kd = (1.0f - fv[i]) * rP[i];
                const f32x2 qv = {bf_lo(rq[i]), bf_hi(rq[i])}; const f32x2 qdv = qv * Pv;
                const int t = 8 * tg + i;
                const unsigned qd = pg8::cvt_pk_bf16(qdv.x, qdv.y);
                *(LAS unsigned*)(Qd + t * QS + 4 * kp) = qd;
                *(unsigned*)(sbase + (size_t)(n * 64 + i) * INC * 2 + voff) = qd;
                *(LAS unsigned*)(Kd + t * QS + 4 * kp) = pg8::cvt_pk_bf16(kd.x, kd.y);
                ksv[i] = kd * totv;
            }
            u32x4 a0, a1, v0, v1;
            a0.x = pg8::cvt_pk_bf16(ksv[0].x, ksv[1].x); a0.y = pg8::cvt_pk_bf16(ksv[2].x, ksv[3].x); a0.z = pg8::cvt_pk_bf16(ksv[4].x, ksv[5].x); a0.w = pg8::cvt_pk_bf16(ksv[6].x, ksv[7].x);
            a1.x = pg8::cvt_pk_bf16(ksv[0].y, ksv[1].y); a1.y = pg8::cvt_pk_bf16(ksv[2].y, ksv[3].y); a1.z = pg8::cvt_pk_bf16(ksv[4].y, ksv[5].y); a1.w = pg8::cvt_pk_bf16(ksv[6].y, ksv[7].y);
            v0.x = (rv[0] & 0xffffu) | (rv[1] << 16); v0.y = (rv[2] & 0xffffu) | (rv[3] << 16); v0.z = (rv[4] & 0xffffu) | (rv[5] << 16); v0.w = (rv[6] & 0xffffu) | (rv[7] << 16);
            v1.x = (rv[0] >> 16) | (rv[1] & 0xffff0000u); v1.y = (rv[2] >> 16) | (rv[3] & 0xffff0000u); v1.z = (rv[4] >> 16) | (rv[5] & 0xffff0000u); v1.w = (rv[6] >> 16) | (rv[7] & 0xffff0000u);
            *(LAS u32x4*)(KsT + (2 * kp) * TS + 16 * tg) = a0; *(LAS u32x4*)(KsT + (2 * kp + 1) * TS + 16 * tg) = a1;
            *(LAS u32x4*)(VT + (2 * kp) * TS + 16 * tg) = v0; *(LAS u32x4*)(VT + (2 * kp + 1) * TS + 16 * tg) = v1;
            if (tg == 0) { *(LAS f32x2*)(DEC + 8 * kp) = totv; *(f32x2*)(cumg + n * 128) = (f32x2){cum0, cum1}; }
            cum0 *= totv.x; cum1 *= totv.y;
        }
        __syncthreads();
        if (n + 1 < 8) {
#pragma unroll
            for (int i = 0; i < 8; ++i) { const char* p = sbase + (size_t)((n + 1) * 64 + i) * INC * 2; rq[i] = *(const unsigned*)(p + voff); rf[i] = *(const unsigned*)(p + HW * 2 + voff); rv[i] = *(const unsigned*)(p + 4 * HW + voff); }
        }
        {
            const int si = w & 3, c20 = 2 * (w >> 2);
            bf16x8 av[4], b0[4], b1[4];
            if (si <= c20 + 1) {
#pragma unroll
                for (int kk = 0; kk < 4; ++kk) { av[kk] = *(const LAS bf16x8*)(Kd + (16 * si + r) * QS + (32 * kk + 8 * q) * 2);
                    b0[kk] = *(const LAS bf16x8*)(Qd + (16 * c20 + r) * QS + (32 * kk + 8 * q) * 2); b1[kk] = *(const LAS bf16x8*)(Qd + (16 * (c20 + 1) + r) * QS + (32 * kk + 8 * q) * 2); }
            }
            __builtin_amdgcn_sched_barrier(0);
            f32x4 acc0 = (f32x4){0.f, 0.f, 0.f, 0.f}, acc1 = (f32x4){0.f, 0.f, 0.f, 0.f};
            if (si <= c20 + 1) {
#pragma unroll
                for (int kk = 0; kk < 4; ++kk) { acc0 = __builtin_amdgcn_mfma_f32_16x16x32_bf16(av[kk], b0[kk], acc0, 0, 0, 0); acc1 = __builtin_amdgcn_mfma_f32_16x16x32_bf16(av[kk], b1[kk], acc1, 0, 0, 0); }
            }
#pragma unroll
            for (int j = 0; j < 4; ++j) { if (si > c20 || (si == c20 && 4 * q + j > r)) acc0[j] = 0.f; if (si == c20 + 1 && 4 * q + j > r) acc1[j] = 0.f; }
            u32x2 pw; pw.x = pg8::cvt_pk_bf16(acc0[0], acc0[1]); pw.y = pg8::cvt_pk_bf16(acc0[2], acc0[3]);
            *(LAS u32x2*)(Pm + (16 * c20 + r) * TS + (16 * si + 4 * q) * 2) = pw;
            pw.x = pg8::cvt_pk_bf16(acc1[0], acc1[1]); pw.y = pg8::cvt_pk_bf16(acc1[2], acc1[3]);
            *(LAS u32x2*)(Pm + (16 * (c20 + 1) + r) * TS + (16 * si + 4 * q) * 2) = pw;
        }
        __syncthreads();
        {
            bf16x8 pa[2], qa[4], bb[6];
#pragma unroll
            for (int kk = 0; kk < 2; ++kk) pa[kk] = *(const LAS bf16x8*)(Pm + (16 * ci + r) * TS + (32 * kk + 8 * q) * 2);
#pragma unroll
            for (int kk = 0; kk < 4; ++kk) qa[kk] = *(const LAS bf16x8*)(Qd + (16 * ci + r) * QS + (32 * kk + 8 * q) * 2);
            bf16_t* op = OLOC + (row0 + (size_t)n * 64 + 16 * ci + r) * HW + h * HD + 64 * vh + 4 * q;
#pragma unroll
            for (int i = 0; i < 4; ++i) {
                const int vt = 4 * vh + i;
#pragma unroll
                for (int kk = 0; kk < 2; ++kk) bb[kk] = *(const LAS bf16x8*)(VT + (16 * vt + r) * TS + (32 * kk + 8 * q) * 2);
#pragma unroll
                for (int kk = 0; kk < 4; ++kk) bb[2 + kk] = *(const LAS bf16x8*)(ST + (16 * vt + r) * QS + (32 * kk + 8 * q) * 2);
                __builtin_amdgcn_sched_barrier(0);
                f32x4 acc = (f32x4){0.f, 0.f, 0.f, 0.f};
#pragma unroll
                for (int kk = 0; kk < 2; ++kk) acc = __builtin_amdgcn_mfma_f32_16x16x32_bf16(bb[kk], pa[kk], acc, 0, 0, 0);
#pragma unroll
                for (int kk = 0; kk < 4; ++kk) acc = __builtin_amdgcn_mfma_f32_16x16x32_bf16(bb[2 + kk], qa[kk], acc, 0, 0, 0);
                { u32x2 ow; ow.x = pg8::cvt_pk_bf16(acc[0], acc[1]); ow.y = pg8::cvt_pk_bf16(acc[2], acc[3]); *(u32x2*)(op + 16 * i) = ow; }
                __builtin_amdgcn_sched_barrier(0);
            }
        }
        __syncthreads();
        {
            const f32x4 dkc = *(const LAS f32x4*)(DEC + (16 * w + 4 * q) * 4);
            bf16x8 ka[2], vb[8];
#pragma unroll
            for (int kk = 0; kk < 2; ++kk) ka[kk] = *(const LAS bf16x8*)(KsT + (16 * w + r) * TS + (32 * kk + 8 * q) * 2);
#pragma unroll
            for (int hf = 0; hf < 2; ++hf) {
#pragma unroll
                for (int t4 = 0; t4 < 4; ++t4)
#pragma unroll
                    for (int kk = 0; kk < 2; ++kk) vb[2 * t4 + kk] = *(const LAS bf16x8*)(VT + (16 * (4 * hf + t4) + r) * TS + (32 * kk + 8 * q) * 2);
                __builtin_amdgcn_sched_barrier(0);
#pragma unroll
                for (int t4 = 0; t4 < 4; ++t4) {
                    const int ni = 4 * hf + t4;
                    f32x4 acc = accS[ni] * dkc;
#pragma unroll
                    for (int kk = 0; kk < 2; ++kk) acc = __builtin_amdgcn_mfma_f32_16x16x32_bf16(ka[kk], vb[2 * t4 + kk], acc, 0, 0, 0);
                    accS[ni] = acc;
                }
                __builtin_amdgcn_sched_barrier(0);
            }
#pragma unroll
            for (int ni = 0; ni < 8; ++ni) { u32x2 sw; sw.x = pg8::cvt_pk_bf16(accS[ni][0], accS[ni][1]); sw.y = pg8::cvt_pk_bf16(accS[ni][2], accS[ni][3]);
                *(LAS u32x2*)(ST + (16 * ni + r) * QS + (16 * w + 4 * q) * 2) = sw; }
        }
    }
    {   f32x4* tg4 = (f32x4*)TG + ((size_t)item * 8 + w) * 8 * 64 + lane;
#pragma unroll
        for (int ni = 0; ni < 8; ++ni) tg4[ni * 64] = accS[ni];
        if (tg == 0) *(f32x2*)(DSEG + (size_t)item * 128 + 2 * kp) = (f32x2){cum0, cum1};
    }
    __syncthreads();
}

__device__ __forceinline__ void hgrn_p2(LAS unsigned char* lds, const bf16_t* PROJ, const bf16_t* OLOC, const float* TG, const float* CUMG, const float* DSEG, const float* nw, bf16_t* MIX, int item, int tid_in) {
    int tid = tid_in; asm volatile("" : "+v"(tid));
    constexpr int QS = 272;
    LAS unsigned char* Qd = lds;
    LAS unsigned char* ST = lds + 17408;
    LAS unsigned char* NRM = ST + 34816;
    LAS unsigned char* OT = NRM + 2048;
    const int lane = tid & 63, w = __builtin_amdgcn_readfirstlane(tid >> 6), r = lane & 15, q = lane >> 4;
    const int b = item >> 5, h = (item >> 2) & 7, g = item & 3;
    const size_t row0 = (size_t)b * SEQ + (size_t)g * 512;
    const int ci = w & 3, vh = w >> 2;
    f32x4 sin[8];
#pragma unroll
    for (int i = 0; i < 8; ++i) sin[i] = (f32x4){0.f, 0.f, 0.f, 0.f};
    for (int gp = 0; gp < g; ++gp) {
        const int it2 = item - g + gp;
        const f32x4 ds = *(const f32x4*)(DSEG + (size_t)it2 * 128 + 16 * w + 4 * q);
        const f32x4* tg4 = (const f32x4*)TG + ((size_t)it2 * 8 + w) * 8 * 64 + lane;
#pragma unroll
        for (int ni = 0; ni < 8; ++ni) sin[ni] = sin[ni] * ds + tg4[ni * 64];
    }
    const float* cumg = CUMG + ((size_t)(b * 8 + h) * 32 + g * 8) * 128 + 16 * w + 4 * q;
    const char* qbase = (const char*)(PROJ + row0 * INC + h * HD);
    const unsigned qoff = (unsigned)(tid >> 4) * (INC * 2) + (unsigned)(tid & 15) * 16u;
    const char* gbase = (const char*)(PROJ + (row0 + 16 * ci) * INC + 3 * HW + h * HD + 64 * vh);
    const unsigned go = (unsigned)r * (INC * 2) + 8u * (unsigned)q;
    const float* nwp = nw + h * HD + 64 * vh + 4 * q;
    f32x4 nv[4];
#pragma unroll
    for (int i = 0; i < 4; ++i) nv[i] = *(const f32x4*)(nwp + 16 * i);
    u32x4 lq[2]; u32x2 lo[4], gt[4]; f32x4 cmn;
#define HP2_LOAD(nn) do { \
        if (g > 0) { _Pragma("unroll") for (int j = 0; j < 2; ++j) lq[j] = *(const u32x4*)(qbase + (size_t)((nn) * 64 + 32 * j) * INC * 2 + qoff); cmn = *(const f32x4*)(cumg + (nn) * 128); } \
        const bf16_t* op_ = OLOC + (row0 + (size_t)(nn) * 64 + 16 * ci + r) * HW + h * HD + 64 * vh + 4 * q; \
        _Pragma("unroll") for (int i = 0; i < 4; ++i) { lo[i] = *(const u32x2*)(op_ + 16 * i); gt[i] = *(const u32x2*)(gbase + (size_t)(nn) * 64 * INC * 2 + (size_t)(32 * i) + go); } \
    } while (0)
    HP2_LOAD(0);
    __syncthreads();
    for (int n = 0; n < 8; ++n) {
        f32x4 o[4]; u32x2 gc[4];
#pragma unroll
        for (int i = 0; i < 4; ++i) { o[i] = (f32x4){bf_lo(lo[i].x), bf_hi(lo[i].x), bf_lo(lo[i].y), bf_hi(lo[i].y)}; gc[i] = gt[i]; }
        if (g > 0) {
            const f32x4 cm = cmn;
#pragma unroll
            for (int ni = 0; ni < 8; ++ni) { const f32x4 sv = sin[ni] * cm; u32x2 sw; sw.x = pg8::cvt_pk_bf16(sv[0], sv[1]); sw.y = pg8::cvt_pk_bf16(sv[2], sv[3]);
                *(LAS u32x2*)(ST + (16 * ni + r) * QS + (16 * w + 4 * q) * 2) = sw; }
#pragma unroll
            for (int j = 0; j < 2; ++j) { const int t = (tid >> 4) + 32 * j, c = tid & 15; *(LAS u32x4*)(Qd + t * QS + c * 16) = lq[j]; }
        }
        __syncthreads();
        if (n + 1 < 8) HP2_LOAD(n + 1);
        if (g > 0) {
            bf16x8 qa[4], bb[4];
#pragma unroll
            for (int kk = 0; kk < 4; ++kk) qa[kk] = *(const LAS bf16x8*)(Qd + (16 * ci + r) * QS + (32 * kk + 8 * q) * 2);
#pragma unroll
            for (int i = 0; i < 4; ++i) {
#pragma unroll
                for (int kk = 0; kk < 4; ++kk) bb[kk] = *(const LAS bf16x8*)(ST + (16 * (4 * vh + i) + r) * QS + (32 * kk + 8 * q) * 2);
                __builtin_amdgcn_sched_barrier(0);
                f32x4 acc = o[i];
#pragma unroll
                for (int kk = 0; kk < 4; ++kk) acc = __builtin_amdgcn_mfma_f32_16x16x32_bf16(bb[kk], qa[kk], acc, 0, 0, 0);
                o[i] = acc;
                __builtin_amdgcn_sched_barrier(0);
            }
        }
        {
            float sq = 0.f;
#pragma unroll
            for (int i = 0; i < 4; ++i) sq += (o[i][0] * o[i][0] + o[i][1] * o[i][1]) + (o[i][2] * o[i][2] + o[i][3] * o[i][3]);
            *(LAS float*)(NRM + ((vh * 4 + q) * 64 + 16 * ci + r) * 4) = sq;
        }
        __syncthreads();
        {
            float ssum = 0.f;
#pragma unroll
            for (int gg = 0; gg < 8; ++gg) ssum += *(const LAS float*)(NRM + (gg * 64 + 16 * ci + r) * 4);
            const float rs = __builtin_amdgcn_rsqf(ssum * (1.0f / HD) + EPS);
            LAS unsigned char* ot = OT + w * 2304;
#pragma unroll
            for (int i = 0; i < 4; ++i) {
                const float g0 = bf_lo(gc[i].x), g1 = bf_hi(gc[i].x), g2 = bf_lo(gc[i].y), g3 = bf_hi(gc[i].y);
                u32x2 ow; ow.x = pg8::cvt_pk_bf16(o[i][0] * rs * nv[i][0] * siluf_(g0), o[i][1] * rs * nv[i][1] * siluf_(g1));
                ow.y = pg8::cvt_pk_bf16(o[i][2] * rs * nv[i][2] * siluf_(g2), o[i][3] * rs * nv[i][3] * siluf_(g3));
                *(LAS u32x2*)(ot + r * 144 + (16 * i + 4 * q) * 2) = ow;
            }
            asm volatile("s_waitcnt lgkmcnt(0)" ::: "memory");
#pragma unroll
            for (int j = 0; j < 2; ++j) { const int rr = (lane >> 3) + 8 * j, pc = lane & 7;
                const u32x4 ov = *(const LAS u32x4*)(ot + rr * 144 + pc * 16);
                *(u32x4*)(MIX + (row0 + (size_t)n * 64 + 16 * ci + rr) * D + h * HD + 64 * vh + pc * 8) = ov; }
        }
        __syncthreads();
    }
#undef HP2_LOAD
}

struct Args { const float* in[16]; float* out; unsigned char* ws; int use_cg; int pad; };

__global__ void __launch_bounds__(512, 2) mk_fwd(Args a) {
    extern __shared__ __attribute__((aligned(16))) unsigned char lds_raw[];
    LAS unsigned char* lds = (LAS unsigned char*)lds_raw;
    cg::grid_group grid = cg::this_grid();
    const int tid = threadIdx.x, lane = tid & 63, wave = __builtin_amdgcn_readfirstlane(tid >> 6);
    const int G = gridDim.x, bid = blockIdx.x;
    unsigned char* ws = a.ws;
    float* ssq0 = (float*)(ws + WS_SSQ); float* ssq1 = ssq0 + M; float* ssq2 = ssq1 + M; float* ssq3 = ssq2 + M;
    float* ssqh = (float*)(ws + WS_SSQH);
    bf16_t* W1GU = (bf16_t*)(ws + WS_W1GU); bf16_t* W1D = (bf16_t*)(ws + WS_W1D); bf16_t* WIN = (bf16_t*)(ws + WS_WIN); bf16_t* WOUT = (bf16_t*)(ws + WS_WOUT);
    bf16_t* W2GU = (bf16_t*)(ws + WS_W2GU); bf16_t* W2D = (bf16_t*)(ws + WS_W2D);
    bf16_t* MIX = (bf16_t*)(ws + WS_MIX); bf16_t* XB = (bf16_t*)(ws + WS_XB); float* OUN = (float*)(ws + WS_XB);
    bf16_t* HB = (bf16_t*)(ws + WS_BIG); bf16_t* PROJ = (bf16_t*)(ws + WS_BIG);
    bf16_t* OLOC = (bf16_t*)a.out;
    float* OLOC_unused = (float*)(ws + WS_XB); (void)OLOC_unused; float* TGS = (float*)(ws + WS_TG); float* CUMG = (float*)(ws + WS_CUM); float* DSEG = (float*)(ws + WS_DSEG);
    const float* x = a.in[0]; float* out = a.out;
    if (tid < 64) ((LAS unsigned*)(lds + LDS_CTL))[tid] = 0u;
    __syncthreads();
    const XcdBarrier xbar = xcd_barrier_post((unsigned*)(ws + WS_BAR), (volatile LAS unsigned*)(lds + LDS_CTL + 32));
#define GRID_BAR() do { if (a.use_cg) grid.sync(); else xcd_barrier(xbar); } while (0)

    {
        LAS float* scr = (LAS float*)(lds + wave * 16384);
        const int gw = bid * 8 + wave, NGW = G * 8;
        constexpr int I_GU = (D / 64) * (FF / 32), I_DN = (FF / 64) * (D / 32), I_IN = (D / 64) * (INC / 32), I_OUT = (D / 64) * (D / 32);
        constexpr int NITEMS = 4 * I_GU + 2 * I_DN + I_IN + I_OUT;
        auto desc = [&](int it) -> P0Desc {
            int r = it;
            if (r < I_GU) return P0Desc{a.in[2], W1GU, a.in[1], D, FF, 1, r}; r -= I_GU;
            if (r < I_GU) return P0Desc{a.in[3], W1GU, a.in[1], D, FF, 2, r}; r -= I_GU;
            if (r < I_DN) return P0Desc{a.in[4], W1D, nullptr, FF, D, 0, r}; r -= I_DN;
            if (r < I_IN) return P0Desc{a.in[6], WIN, a.in[5], D, INC, 3, r}; r -= I_IN;
            if (r < I_OUT) return P0Desc{a.in[10], WOUT, nullptr, D, D, 0, r}; r -= I_OUT;
            if (r < I_GU) return P0Desc{a.in[12], W2GU, a.in[11], D, FF, 1, r}; r -= I_GU;
            if (r < I_GU) return P0Desc{a.in[13], W2GU, a.in[11], D, FF, 2, r}; r -= I_GU;
            return P0Desc{a.in[14], W2D, nullptr, FF, D, 0, r};
        };
        {
            f32x4 va[8], vb[8]; float sa[8], sb[8];
            int it = gw;
            P0Desc da = desc(it < NITEMS ? it : 0), db = da;
            if (it < NITEMS) p0_load(da, va, sa, lane);
            while (it < NITEMS) {
                const int itb = it + NGW;
                if (itb < NITEMS) { db = desc(itb); p0_load(db, vb, sb, lane); }
                p0_finish(da, va, sa, scr, lane);
                if (itb >= NITEMS) break;
                const int ita = itb + NGW;
                if (ita < NITEMS) { da = desc(ita); p0_load(da, va, sa, lane); }
                p0_finish(db, vb, sb, scr, lane);
                it = ita;
            }
        }
        for (int m = gw; m < M; m += NGW) {
            const f32x4* xr = (const f32x4*)(x + (size_t)m * D) + lane; u32x2* o8 = (u32x2*)(XB + (size_t)m * D) + lane; float s = 0.f;
#pragma unroll
            for (int j = 0; j < 8; ++j) { const f32x4 v = xr[64 * j]; s += (v[0] * v[0] + v[1] * v[1]) + (v[2] * v[2] + v[3] * v[3]); u32x2 w; w.x = pk2(v[0], v[1]); w.y = pk2(v[2], v[3]); o8[64 * j] = w; }
            s = wave_sum(s);
            if (lane == 0) ssq0[m] = s;
        }
        for (int i = bid * 512 + tid; i < 3 * M; i += G * 512) ssq1[i] = 0.f;
    }
    GRID_BAR();

    { pg8::Gemm g{XB, W1GU, M, 2 * FF, D}; pg8::StaticOrder S; S.init(M, 2 * FF, G, bid); pg8::EpiSwiGLU E{HB, ssq0}; pg8::gemm_phase<pg8::EpiSwiGLU>(lds, g, S, E); }
    GRID_BAR();
    { pg8::Gemm g{HB, W1D, M, D, FF}; pg8::StaticOrder S; S.init(M, D, G, bid); pg8::EpiResid<true, true> E{nullptr, XB, nullptr, XB, ssq1, 0.5f}; pg8::gemm_phase<pg8::EpiResid<true, true>>(lds, g, S, E); }
    GRID_BAR();
    { pg8::Gemm g{XB, WIN, M, INC, D}; pg8::StaticOrder S; S.init(M, INC, G, bid); pg8::EpiProj E{PROJ, ssq1}; pg8::gemm_phase<pg8::EpiProj>(lds, g, S, E); }
    GRID_BAR();

    for (int item = bid; item < 256; item += G) hgrn_p1(lds, PROJ, a.in[7], OLOC, TGS, CUMG, DSEG, item, tid);
    {
        const float* cw = a.in[9];
        const size_t stride = (size_t)G * 512, total = (size_t)M * 128;
        const int c0 = (tid & 127) * 8;
        f32x4 wa[3], wb[3];
#pragma unroll
        for (int d = 0; d < 3; ++d) { wa[d] = *(const f32x4*)(cw + d * HW + c0); wb[d] = *(const f32x4*)(cw + d * HW + c0 + 4); }
        for (size_t idx0 = (size_t)bid * 512 + tid; idx0 < total; idx0 += 2 * stride) {
            u32x4 bb[2], cc[2][3]; float ok[2][3]; size_t rows[2]; bool have[2];
#pragma unroll
            for (int u = 0; u < 2; ++u) {
                const size_t idx = idx0 + u * stride; have[u] = idx < total;
                const size_t row = have[u] ? (idx >> 7) : (idx0 >> 7); rows[u] = row; const int t = (int)(row & (SEQ - 1));
                const bf16_t* pr = PROJ + row * INC;
                bb[u] = *(const u32x4*)(pr + 4 * HW + c0);
#pragma unroll
                for (int d = 0; d < 3; ++d) { const bool v = (t - 2 + d) >= 0; ok[u][d] = v ? 1.f : 0.f; const bf16_t* p2 = v ? pr - (size_t)(2 - d) * INC : pr;
                    cc[u][d] = *(const u32x4*)(p2 + 5 * HW + c0); }
            }
#pragma unroll
            for (int u = 0; u < 2; ++u) {
                float acc8[8];
#pragma unroll
                for (int j = 0; j < 8; ++j) acc8[j] = 0.f;
#pragma unroll
                for (int d = 0; d < 3; ++d) {
                    const u32x4 c4 = cc[u][d]; const float m = ok[u][d];
                    const float cv[8] = {bf_lo(c4.x), bf_hi(c4.x), bf_lo(c4.y), bf_hi(c4.y), bf_lo(c4.z), bf_hi(c4.z), bf_lo(c4.w), bf_hi(c4.w)};
#pragma unroll
                    for (int j = 0; j < 4; ++j) { acc8[j] += (wa[d][j] * m) * cv[j]; acc8[4 + j] += (wb[d][j] * m) * cv[4 + j]; }
                }
                const u32x4 b4 = bb[u];
                const float bv[8] = {bf_lo(b4.x), bf_hi(b4.x), bf_lo(b4.y), bf_hi(b4.y), bf_lo(b4.z), bf_hi(b4.z), bf_lo(b4.w), bf_hi(b4.w)};
                u32x4 w; w.x = pk2(bv[0] * acc8[0], bv[1] * acc8[1]); w.y = pk2(bv[2] * acc8[2], bv[3] * acc8[3]); w.z = pk2(bv[4] * acc8[4], bv[5] * acc8[5]); w.w = pk2(bv[6] * acc8[6], bv[7] * acc8[7]);
                if (have[u]) *(u32x4*)(MIX + rows[u] * D + HW + c0) = w;
            }
        }
    }
    GRID_BAR();
    for (int item = bid; item < 256; item += G) hgrn_p2(lds, PROJ, OLOC, TGS, CUMG, DSEG, a.in[8], MIX, item, tid);
    GRID_BAR();


    { pg8::Gemm g{MIX, WOUT, M, D, D}; pg8::StaticOrder S; S.init(M, D, G, bid); pg8::EpiResid<true, true> E{nullptr, XB, nullptr, XB, ssq2, 1.0f}; pg8::gemm_phase<pg8::EpiResid<true, true>>(lds, g, S, E); }
    GRID_BAR();
    { pg8::Gemm g{XB, W2GU, M, 2 * FF, D}; pg8::StaticOrder S; S.init(M, 2 * FF, G, bid); pg8::EpiSwiGLU E{HB, ssq2}; pg8::gemm_phase<pg8::EpiSwiGLU>(lds, g, S, E); }
    GRID_BAR();
    { pg8::Gemm g{HB, W2D, M, D, FF}; pg8::StaticOrder S; S.init(M, D, G, bid); pg8::EpiResid<true, true> E{nullptr, XB, nullptr, XB, ssq3, 0.5f}; pg8::gemm_phase<pg8::EpiResid<true, true>>(lds, g, S, E); }
    GRID_BAR();
    {
        const float* fw = a.in[15];
        for (size_t idx = (size_t)bid * 512 + tid; idx < (size_t)M * (D / 8); idx += (size_t)G * 512) {
            const size_t row = idx >> 8; const int c8 = (int)(idx & 255) * 8;
            const float rs = __builtin_amdgcn_rsqf(ssq3[row] * (1.0f / D) + EPS);
            const u32x4 xv = __builtin_nontemporal_load((const u32x4*)(XB + row * D + c8)); const f32x4 w0 = *(const f32x4*)(fw + c8), w1 = *(const f32x4*)(fw + c8 + 4);
            const f32x4 v0 = (f32x4){bf_lo(xv.x), bf_hi(xv.x), bf_lo(xv.y), bf_hi(xv.y)}, v1 = (f32x4){bf_lo(xv.z), bf_hi(xv.z), bf_lo(xv.w), bf_hi(xv.w)};
            __builtin_nontemporal_store(v0 * rs * w0, (f32x4*)(out + row * D + c8)); __builtin_nontemporal_store(v1 * rs * w1, (f32x4*)(out + row * D + c8 + 4));
        }
    }
}

extern "C" void kernel_launch(void* const* d_in, const int* in_sizes, int n_in, void* d_out, int out_size,
                              void* d_ws, size_t ws_size, hipStream_t stream) {
    static int grid = 0;
    if (grid == 0) {
        if (n_in != 16 || in_sizes[0] != M * D || out_size != M * D || ws_size < WS_END) { fprintf(stderr, "kernel_launch: unexpected shapes / workspace (%d inputs, ws %zu)\n", n_in, ws_size); grid = -1; return; }
        int dev = 0, cus = 0, per_cu = 0;
        (void)hipGetDevice(&dev);
        (void)hipDeviceGetAttribute(&cus, hipDeviceAttributeMultiprocessorCount, dev);
        (void)hipFuncSetAttribute((const void*)mk_fwd, hipFuncAttributeMaxDynamicSharedMemorySize, LDS_BYTES);
        (void)hipOccupancyMaxActiveBlocksPerMultiprocessor(&per_cu, (const void*)mk_fwd, 512, LDS_BYTES);
        if (per_cu < 1) { fprintf(stderr, "kernel_launch: occupancy query says %d\n", per_cu); per_cu = 1; }
        grid = cus * per_cu;
    }
    if (grid < 0) return;
    Args a{};
    for (int i = 0; i < 16; ++i) a.in[i] = (const float*)d_in[i];
    a.out = (float*)d_out; a.ws = (unsigned char*)d_ws; a.use_cg = 0; a.pad = 0;
    if (hipMemsetAsync((char*)d_ws + WS_BAR, 0, BAR_BYTES, stream) != hipSuccess) { fprintf(stderr, "kernel_launch: memset failed\n"); return; }
    void* args[] = {&a};
    hipError_t e = hipLaunchCooperativeKernel((const void*)mk_fwd, dim3(grid), dim3(512), args, LDS_BYTES, stream);
    if (e != hipSuccess) fprintf(stderr, "cooperative launch failed: %s (grid %d)\n", hipGetErrorString(e), grid);
}
```
